# Optimizing an MI355X kernel written in HIP

```python
import jax, jax.numpy as jnp
from jax import lax
import numpy as np

D_MODEL = 1024
BATCH = 4
SEQ = 8192
DEPTH = 2

GRID_W = 64
CTX_LEN = 256
EPS = 1e-6
ROPE_BASE = 10000.0
N_MOD = 9

D_FF = 2816

RET_HEADS = 8
RET_QK_DIM = 64
RET_V_DIM = 128
RET_CHUNK = 128
RET_QK_WIDTH = RET_HEADS * RET_QK_DIM
RET_V_WIDTH = RET_HEADS * RET_V_DIM
RET_SCALE = RET_QK_DIM ** -0.5

MLA_HEADS = 8
MLA_Q_RANK = 384
MLA_KV_RANK = 256
MLA_NOPE_DIM = 64
MLA_ROPE_DIM = 32
MLA_V_DIM = 64
MLA_QK_DIM = MLA_NOPE_DIM + MLA_ROPE_DIM
MLA_OUT_WIDTH = MLA_HEADS * MLA_V_DIM
MLA_SCALE = MLA_QK_DIM ** -0.5
Q_BLOCK = 128

IN_PARTS = (
    ("ret_q", RET_QK_WIDTH),
    ("ret_k", RET_QK_WIDTH),
    ("ret_v", RET_V_WIDTH),
    ("ret_g", RET_V_WIDTH),
    ("mla_dq", MLA_Q_RANK),
    ("mla_dkv", MLA_KV_RANK),
    ("mla_kr", MLA_ROPE_DIM),
    ("gate_ret", D_MODEL),
    ("gate_mla", D_MODEL),
)
IN_WIDTH = 2 * RET_QK_WIDTH + 2 * RET_V_WIDTH + MLA_Q_RANK + MLA_KV_RANK + MLA_ROPE_DIM + 2 * D_MODEL
ALL_PARTS = ("ret_q", "ret_k", "ret_v", "ret_g", "mla_dq", "mla_dkv", "mla_kr", "gate_ret", "gate_mla")
CTX_KV_PARTS = ("ret_k", "ret_v", "mla_dkv", "mla_kr")

kernel_name = "hybrid_retention_mla_macaron_dit"


def rmsnorm(x, gain=None):
    xf = x.astype(jnp.float32)
    y = xf * lax.rsqrt(jnp.mean(xf * xf, axis=-1, keepdims=True) + EPS)
    if gain is not None:
        y = y * gain.astype(jnp.float32)
    return y.astype(x.dtype)


def modulate(h, shift, scale):
    return h * (1.0 + scale) + shift


def swiglu(h, w1, w3, w2):
    return (jax.nn.silu(h @ w1) * (h @ w3)) @ w2


def heads(t, dim):
    return t.reshape(t.shape[0], t.shape[1], -1, dim)


def flip(t):
    return jnp.flip(t, axis=1)


def axial_rope_tables(length, n_freq):
    rows = length // GRID_W
    row = jnp.repeat(jnp.arange(rows, dtype=jnp.float32), GRID_W)
    col = jnp.tile(jnp.arange(GRID_W, dtype=jnp.float32), rows)
    inv_freq = jnp.power(ROPE_BASE, -jnp.arange(n_freq, dtype=jnp.float32) / n_freq)
    ang_r = row[:, None] * inv_freq[None, :]
    ang_c = col[:, None] * inv_freq[None, :]
    return (jnp.cos(ang_r), jnp.sin(ang_r), jnp.cos(ang_c), jnp.sin(ang_c))


def _rotate(x, cos, sin):
    n = cos.shape[-1]
    x1, x2 = x[..., :n], x[..., n:]
    cos = cos[:, None, :]
    sin = sin[:, None, :]
    return jnp.concatenate([x1 * cos - x2 * sin, x2 * cos + x1 * sin], axis=-1)


def axial_rope(x, tables):
    cos_r, sin_r, cos_c, sin_c = tables
    half = x.shape[-1] // 2
    xf = x.astype(jnp.float32)
    out = jnp.concatenate([_rotate(xf[..., :half], cos_r, sin_r),
                           _rotate(xf[..., half:], cos_c, sin_c)], axis=-1)
    return out.astype(x.dtype)


def in_projection(h, w_in, names):
    offsets = {}
    start = 0
    for name, width in IN_PARTS:
        offsets[name] = (start, width)
        start += width
    w = jnp.concatenate([w_in[:, offsets[n][0]:offsets[n][0] + offsets[n][1]] for n in names], axis=1)
    y = h @ w
    out = {}
    pos = 0
    for n in names:
        width = offsets[n][1]
        out[n] = y[..., pos:pos + width]
        pos += width
    return out


def retention_chunkwise(q, k, v, log_g, state0):
    B, L, H, dk = q.shape
    dv = v.shape[-1]
    C = RET_CHUNK
    N = L // C
    q = q.astype(jnp.float32).reshape(B, N, C, H, dk)
    k = k.astype(jnp.float32).reshape(B, N, C, H, dk)
    v = v.astype(jnp.float32).reshape(B, N, C, H, dv)
    idx = jnp.arange(C, dtype=jnp.float32)
    diff = idx[:, None] - idx[None, :]
    decay_intra = jnp.where(diff >= 0, jnp.exp(log_g[:, None, None] * jnp.maximum(diff, 0.0)), 0.0)
    scores = jnp.einsum('bnihd,bnjhd->bnhij', q, k) * decay_intra
    o_intra = jnp.einsum('bnhij,bnjhe->bnihe', scores, v)
    k_dec = k * jnp.exp(log_g[None, :] * (C - 1.0 - idx)[:, None])[:, :, None]
    kv_chunk = jnp.einsum('bnjhd,bnjhe->nbhde', k_dec, v)
    chunk_decay = jnp.exp(log_g * C)[None, :, None, None]

    def step(state, kv_n):
        return chunk_decay * state + kv_n, state

    final_state, state_prev = lax.scan(step, state0, kv_chunk)
    q_dec = q * jnp.exp(log_g[None, :] * (idx + 1.0)[:, None])[:, :, None]
    o_cross = jnp.einsum('bnihd,nbhde->bnihe', q_dec, state_prev)
    return (o_intra + o_cross).reshape(B, L, H, dv), final_state


def decayed_state(k, v, log_g):
    L = k.shape[1]
    pos = jnp.arange(L, dtype=jnp.float32)
    w = jnp.exp(log_g[None, :] * (L - 1.0 - pos)[:, None])
    return jnp.einsum('blhd,lh,blhe->bhde', k.astype(jnp.float32), w, v.astype(jnp.float32))


def retention_output(o, g_raw, ret_gn, w_ret_out):
    B, L = o.shape[0], o.shape[1]
    mu = jnp.mean(o, axis=-1, keepdims=True)
    var = jnp.mean(jnp.square(o - mu), axis=-1, keepdims=True)
    n = ((o - mu) * lax.rsqrt(var + EPS)).reshape(B, L, RET_V_WIDTH) * ret_gn.astype(jnp.float32)
    return (jax.nn.silu(g_raw) * n.astype(g_raw.dtype)) @ w_ret_out


def ret_qk(t, rope):
    t = heads(t, RET_QK_DIM)
    return t if rope is None else axial_rope(t, rope)


def mla_queries(dq, q_norm, w_uq, rope):
    q = heads(rmsnorm(dq, q_norm) @ w_uq, MLA_QK_DIM)
    if rope is None:
        return q
    return jnp.concatenate([q[..., :MLA_NOPE_DIM], axial_rope(q[..., MLA_NOPE_DIM:], rope)], axis=-1)


def mla_keys_values(dkv, kr, kv_norm, w_ukv, rope):
    kv = heads(rmsnorm(dkv, kv_norm) @ w_ukv, MLA_NOPE_DIM + MLA_V_DIM)
    k_nope, v = kv[..., :MLA_NOPE_DIM], kv[..., MLA_NOPE_DIM:]
    k_rope = kr[:, :, None, :]
    if rope is not None:
        k_rope = axial_rope(k_rope, rope)
    k_rope = jnp.broadcast_to(k_rope, k_nope.shape[:-1] + (MLA_ROPE_DIM,))
    return jnp.concatenate([k_nope, k_rope], axis=-1), v


def softmax_attend(q, k, v):
    s = jnp.einsum('bqhd,bkhd->bhqk', q, k).astype(jnp.float32) * MLA_SCALE
    p = jax.nn.softmax(s, axis=-1).astype(v.dtype)
    return jnp.einsum('bhqk,bkhe->bqhe', p, v)


def blocked_attend(q, k, v):
    B, L, H, d = q.shape
    qb = q.reshape(B, L // Q_BLOCK, Q_BLOCK, H, d).transpose(1, 0, 2, 3, 4)
    o = lax.map(lambda blk: softmax_attend(blk, k, v), qb)
    return o.transpose(1, 0, 2, 3, 4).reshape(B, L, H, v.shape[-1])


def merge(ret_b, mla_b, gate_ret, gate_mla, w_o):
    return (jax.nn.sigmoid(gate_ret) * ret_b + jax.nn.sigmoid(gate_mla) * mla_b) @ w_o


def token_mixer(h_lat, h_ctx, w_in, ret_decay_fwd, ret_decay_bwd, ret_gn,
                mla_q_norm, mla_kv_norm, w_uq, w_ukv, w_ret_out, w_mla_out, w_o,
                ret_rope, mla_rope, need_ctx_out):
    B, L = h_lat.shape[0], h_lat.shape[1]
    log_g_f = -jnp.exp(ret_decay_fwd.astype(jnp.float32))
    log_g_b = -jnp.exp(ret_decay_bwd.astype(jnp.float32))

    pl = in_projection(h_lat, w_in, ALL_PARTS)
    pc = in_projection(h_ctx, w_in, ALL_PARTS if need_ctx_out else CTX_KV_PARTS)

    kc = ret_qk(pc["ret_k"], None) * RET_SCALE
    vc = heads(pc["ret_v"], RET_V_DIM)
    if need_ctx_out:
        zero_state = jnp.zeros((B, RET_HEADS, RET_QK_DIM, RET_V_DIM), jnp.float32)
        qc = ret_qk(pc["ret_q"], None)
        oc_f, sc_f = retention_chunkwise(qc, kc, vc, log_g_f, zero_state)
        oc_b, sc_b = retention_chunkwise(flip(qc), flip(kc), flip(vc), log_g_b, zero_state)
        ret_c = retention_output(oc_f + flip(oc_b), pc["ret_g"], ret_gn, w_ret_out)
    else:
        sc_f = decayed_state(kc, vc, log_g_f)
        sc_b = decayed_state(flip(kc), flip(vc), log_g_b)

    ql = ret_qk(pl["ret_q"], ret_rope)
    kl = ret_qk(pl["ret_k"], ret_rope) * RET_SCALE
    vl = heads(pl["ret_v"], RET_V_DIM)
    ol_f, _ = retention_chunkwise(ql, kl, vl, log_g_f, sc_f)
    ol_b, _ = retention_chunkwise(flip(ql), flip(kl), flip(vl), log_g_b, sc_b)
    ret_l = retention_output(ol_f + flip(ol_b), pl["ret_g"], ret_gn, w_ret_out)

    kc_m, vc_m = mla_keys_values(pc["mla_dkv"], pc["mla_kr"], mla_kv_norm, w_ukv, None)
    ql_m = mla_queries(pl["mla_dq"], mla_q_norm, w_uq, mla_rope)
    kl_m, vl_m = mla_keys_values(pl["mla_dkv"], pl["mla_kr"], mla_kv_norm, w_ukv, mla_rope)
    k_all = jnp.concatenate([kl_m, kc_m], axis=1)
    v_all = jnp.concatenate([vl_m, vc_m], axis=1)
    mla_l = blocked_attend(ql_m, k_all, v_all).reshape(B, L, MLA_OUT_WIDTH) @ w_mla_out
    out_lat = merge(ret_l, mla_l, pl["gate_ret"], pl["gate_mla"], w_o)

    if not need_ctx_out:
        return out_lat, None
    qc_m = mla_queries(pc["mla_dq"], mla_q_norm, w_uq, None)
    mla_c = softmax_attend(qc_m, kc_m, vc_m).reshape(B, h_ctx.shape[1], MLA_OUT_WIDTH) @ w_mla_out
    out_ctx = merge(ret_c, mla_c, pc["gate_ret"], pc["gate_mla"], w_o)
    return out_lat, out_ctx


def setup_inputs(seed: int = 0) -> dict:
    key = jax.random.key(seed)
    ks = jax.random.split(key, 32)
    f32 = jnp.float32

    def nrm(k, shape, scale):
        return jax.random.normal(k, shape, f32) * scale

    base_decay = jnp.log(-jnp.log1p(-jnp.power(2.0, -5.0 - jnp.arange(RET_HEADS, dtype=f32))))
    return {
        "x": nrm(ks[0], (BATCH, SEQ, D_MODEL), 1.0),
        "c": nrm(ks[1], (BATCH, D_MODEL), 1.0),
        "ctx": nrm(ks[2], (BATCH, CTX_LEN, D_MODEL), 1.0),
        "c_ctx": nrm(ks[3], (D_MODEL,), 1.0),
        "w_ada": nrm(ks[4], (DEPTH, D_MODEL, N_MOD * D_MODEL), 0.5 * D_MODEL ** -0.5),
        "b_ada": nrm(ks[5], (DEPTH, N_MOD * D_MODEL), 0.02),
        "ffn1_w1": nrm(ks[6], (DEPTH, D_MODEL, D_FF), D_MODEL ** -0.5),
        "ffn1_w3": nrm(ks[7], (DEPTH, D_MODEL, D_FF), D_MODEL ** -0.5),
        "ffn1_w2": nrm(ks[8], (DEPTH, D_FF, D_MODEL), D_FF ** -0.5),
        "ffn2_w1": nrm(ks[9], (DEPTH, D_MODEL, D_FF), D_MODEL ** -0.5),
        "ffn2_w3": nrm(ks[10], (DEPTH, D_MODEL, D_FF), D_MODEL ** -0.5),
        "ffn2_w2": nrm(ks[11], (DEPTH, D_FF, D_MODEL), D_FF ** -0.5),
        "w_in": nrm(ks[12], (DEPTH, D_MODEL, IN_WIDTH), D_MODEL ** -0.5),
        "ret_decay_fwd": base_decay[None, :] + nrm(ks[13], (DEPTH, RET_HEADS), 0.05),
        "ret_decay_bwd": base_decay[None, :] + nrm(ks[14], (DEPTH, RET_HEADS), 0.05),
        "ret_gn": 1.0 + nrm(ks[15], (DEPTH, RET_V_WIDTH), 0.05),
        "mla_q_norm": 1.0 + nrm(ks[16], (DEPTH, MLA_Q_RANK), 0.05),
        "mla_kv_norm": 1.0 + nrm(ks[17], (DEPTH, MLA_KV_RANK), 0.05),
        "w_uq": nrm(ks[18], (DEPTH, MLA_Q_RANK, MLA_HEADS * MLA_QK_DIM), MLA_Q_RANK ** -0.5),
        "w_ukv": nrm(ks[19], (DEPTH, MLA_KV_RANK, MLA_HEADS * (MLA_NOPE_DIM + MLA_V_DIM)), MLA_KV_RANK ** -0.5),
        "w_ret_out": nrm(ks[20], (DEPTH, RET_V_WIDTH, D_MODEL), RET_V_WIDTH ** -0.5),
        "w_mla_out": nrm(ks[21], (DEPTH, MLA_OUT_WIDTH, D_MODEL), MLA_OUT_WIDTH ** -0.5),
        "w_o": nrm(ks[22], (DEPTH, D_MODEL, D_MODEL), D_MODEL ** -0.5),
        "final_norm": 1.0 + nrm(ks[23], (D_MODEL,), 0.05),
    }


def reference(x, c, ctx, c_ctx, w_ada, b_ada, ffn1_w1, ffn1_w3, ffn1_w2,
              ffn2_w1, ffn2_w3, ffn2_w2, w_in, ret_decay_fwd, ret_decay_bwd, ret_gn,
              mla_q_norm, mla_kv_norm, w_uq, w_ukv, w_ret_out, w_mla_out, w_o, final_norm):
    seq_len = x.shape[1]
    ret_rope = axial_rope_tables(seq_len, RET_QK_DIM // 4)
    mla_rope = axial_rope_tables(seq_len, MLA_ROPE_DIM // 4)
    silu_c = jax.nn.silu(c)
    silu_cc = jax.nn.silu(c_ctx)
    xc = ctx
    for l in range(DEPTH):
        last = l == DEPTH - 1
        mod = (silu_c @ w_ada[l] + b_ada[l])[:, None, :]
        mod_c = (silu_cc @ w_ada[l] + b_ada[l])[None, None, :]
        sh1, sc1, g1, sh2, sc2, g2, sh3, sc3, g3 = jnp.split(mod, N_MOD, axis=-1)
        csh1, csc1, cg1, csh2, csc2, cg2, csh3, csc3, cg3 = jnp.split(mod_c, N_MOD, axis=-1)

        x = x + 0.5 * g1 * swiglu(modulate(rmsnorm(x), sh1, sc1), ffn1_w1[l], ffn1_w3[l], ffn1_w2[l])
        xc = xc + 0.5 * cg1 * swiglu(modulate(rmsnorm(xc), csh1, csc1), ffn1_w1[l], ffn1_w3[l], ffn1_w2[l])

        o_lat, o_ctx = token_mixer(
            modulate(rmsnorm(x), sh2, sc2), modulate(rmsnorm(xc), csh2, csc2),
            w_in[l], ret_decay_fwd[l], ret_decay_bwd[l], ret_gn[l],
            mla_q_norm[l], mla_kv_norm[l], w_uq[l], w_ukv[l],
            w_ret_out[l], w_mla_out[l], w_o[l], ret_rope, mla_rope, not last)
        x = x + g2 * o_lat

        x = x + 0.5 * g3 * swiglu(modulate(rmsnorm(x), sh3, sc3), ffn2_w1[l], ffn2_w3[l], ffn2_w2[l])
        if not last:
            xc = xc + cg2 * o_ctx
            xc = xc + 0.5 * cg3 * swiglu(modulate(rmsnorm(xc), csh3, csc3), ffn2_w1[l], ffn2_w3[l], ffn2_w2[l])
    return rmsnorm(x, final_norm)
```

```cpp
#define MK_N_LAUNCHES 1
#define ATT_R64 1
#include <hip/hip_runtime.h>
#include <hip/hip_cooperative_groups.h>
#include <cstdio>
#include <cstdint>
#include <cmath>
namespace cg = cooperative_groups;
namespace pg8 {
#define PG8_LAS __attribute__((address_space(3)))
typedef unsigned short bf16_t;
typedef short bf16x8 __attribute__((ext_vector_type(8)));
typedef float f32x4 __attribute__((ext_vector_type(4)));
typedef unsigned u32x4 __attribute__((ext_vector_type(4)));
constexpr int BM = 256, BK = 64, HALF = 128, HTB = HALF * BK * 2  , STAGE_BYTES = 8 * HTB, NXCD = 8, WGM = 8;

__host__ __device__ __forceinline__ int lds_byte(int r, int c) { const int st = (r >> 4) * 2 + (c >> 5), rr = r & 15, cc = c & 31, ob = rr * 64 + cc * 2; return st * 1024 + (ob ^ (((ob >> 9) & 1) << 5)); }
__host__ __device__ __forceinline__ void stage_rc(int b, int& R, int& C) { const int st = b / 1024, sb = b % 1024, swz = sb ^ (((sb >> 9) & 1) << 5); R = (st >> 1) * 16 + swz / 64; C = (st & 1) * 32 + (swz % 64) / 2; }
__host__ __device__ __forceinline__ int perm32(int rho) { const int n = rho >> 4, i = rho & 15; return 8 * (i >> 2) + 4 * n + (i & 3); }

struct Unit { int pm, pn; };
struct Gemm { const bf16_t* A; const bf16_t* Bt; int M, N, K, lda; };

struct StaticOrder {
    int nM, nN, nwg, G, c;
    __host__ __device__ void init(int M, int N, int G_, int c_) { nM = M / BM; nN = N / BM; nwg = nM * nN; G = G_; c = c_; }
    __host__ __device__ bool next(int i, Unit& u) const {
        const long L = (long)i * G + c; if (L >= nwg) return false;
        int wgid = (int)L; { const int q = nwg / NXCD, r = nwg % NXCD, xcd = wgid % NXCD, off = wgid / NXCD; wgid = (xcd < r ? xcd * (q + 1) : r * (q + 1) + (xcd - r) * q) + off; }
        const int nig = WGM * nN, gid = wgid / nig, fm = gid * WGM, gsz = (nM - fm) < WGM ? (nM - fm) : WGM;
        u.pm = fm + ((wgid % nig) % gsz); u.pn = (wgid % nig) / gsz; return true;
    }
    __device__ __forceinline__ void a_ready(const Unit&) const {}
    __device__ __forceinline__ void done(const Unit&) const {}
};

__device__ __forceinline__ unsigned cvt_pk_bf16(float lo, float hi) { unsigned r; asm volatile("v_cvt_pk_bf16_f32 %0, %1, %2" : "=v"(r) : "v"(lo), "v"(hi)); return r; }
typedef float f32x2 __attribute__((ext_vector_type(2)));
template <class Epi, class Sched, bool ALIGN_EPI = false, bool SP2 = false>
__device__ __forceinline__ void gemm_phase(PG8_LAS unsigned char* lds, const Gemm g, const Sched& S, const Epi& E) {
    int tid_ = threadIdx.x; asm volatile("" : "+v"(tid_)); const int tid = tid_, wid = __builtin_amdgcn_readfirstlane(tid >> 6), lane = tid & 63, wr = wid >> 2, wc = wid & 3, fr = lane & 15, fq = lane >> 4;
    const int K = g.K, nt = K / BK;
    unsigned voffA[2], voffB[2];
#pragma unroll
    for (int i = 0; i < 2; ++i) { int R, C; stage_rc(tid * 16 + i * 8192, R, C); const int Rb = Epi::PERM ? ((R & ~31) + perm32(R & 31)) : R;
        voffA[i] = (unsigned)(R * g.lda + C) * 2u; voffB[i] = (unsigned)(Rb * K + C) * 2u; }
    const size_t kstep = (size_t)(BK * 2);
    const size_t hstepA = (size_t)HALF * g.lda * 2, hstepB = (size_t)HALF * K * 2;
    const size_t tstepA = 2 * hstepA, tstepB = 2 * hstepB;
    const unsigned ldsw = (unsigned)wid * 1024u;
    const int aoff = lds_byte(wr * 64 + fr, fq * 8), boff = lds_byte(wc * 32 + fr, fq * 8);
#define PG8_SA(b, h) (((b) * 2 + (h)) * HTB)
#define PG8_SB(b, h) ((4 + (b) * 2 + (h)) * HTB)
#define PG8_STAGE(bufoff, gbase, voff) do { _Pragma("unroll") for (int _i = 0; _i < 2; ++_i) \
        __builtin_amdgcn_global_load_lds((const unsigned*)((const char*)(gbase) + (voff)[_i]), (PG8_LAS unsigned*)(lds + (bufoff) + ldsw + _i * 8192), 16, 0, 0); } while (0)
#define PG8_LDA(dst, b, h) do { _Pragma("unroll") for (int m = 0; m < 4; ++m) _Pragma("unroll") for (int k = 0; k < 2; ++k) dst[m][k] = *(const PG8_LAS bf16x8*)(lds + PG8_SA(b, h) + aoff + m * 2048 + k * 1024); } while (0)
#define PG8_LDB(dst, b, h) do { _Pragma("unroll") for (int n = 0; n < 2; ++n) _Pragma("unroll") for (int k = 0; k < 2; ++k) dst[n][k] = *(const PG8_LAS bf16x8*)(lds + PG8_SB(b, h) + boff + n * 2048 + k * 1024); } while (0)
#define PG8_MMA(ai, bj, At, Bt) do { __builtin_amdgcn_s_setprio(1); _Pragma("unroll") for (int m = 0; m < 4; ++m) _Pragma("unroll") for (int n = 0; n < 2; ++n) _Pragma("unroll") for (int k = 0; k < 2; ++k) \
        acc[ai][bj][m][n] = __builtin_amdgcn_mfma_f32_16x16x32_bf16(Bt[n][k], At[m][k], acc[ai][bj][m][n], 0, 0, 0); __builtin_amdgcn_s_setprio(0); } while (0)
#define PG8_WAIT_V(n) asm volatile("s_waitcnt vmcnt(" #n ")" ::: "memory")
#define PG8_WAIT_L(n) asm volatile("s_waitcnt lgkmcnt(" #n ")" ::: "memory")
#define PG8_BAR __builtin_amdgcn_s_barrier()
#define PG8_SCHED __builtin_amdgcn_sched_barrier(0)
    Unit cur, nxt; int ui = 0;
    if (!S.next(0, cur)) return;
    f32x4 acc[2][2][4][2];
#pragma unroll
    for (int a = 0; a < 2; ++a)
#pragma unroll
        for (int b = 0; b < 2; ++b)
#pragma unroll
            for (int m = 0; m < 4; ++m)
#pragma unroll
                for (int n = 0; n < 2; ++n) acc[a][b][m][n] = (f32x4){0.f, 0.f, 0.f, 0.f};
    bf16x8 At[4][2], B0[2][2], B1[2][2];
    const char* cA = (const char*)g.A + (size_t)cur.pm * tstepA; const char* cB = (const char*)g.Bt + (size_t)cur.pn * tstepB;
    S.a_ready(cur);
    if constexpr (SP2) {
        PG8_STAGE(PG8_SB(0, 0), cB, voffB); PG8_STAGE(PG8_SB(0, 1), cB + hstepB, voffB); PG8_STAGE(PG8_SA(0, 0), cA, voffA); PG8_STAGE(PG8_SA(0, 1), cA + hstepA, voffA);
        if (wr == 1) PG8_BAR;
        PG8_WAIT_V(2); PG8_BAR;
        PG8_STAGE(PG8_SB(1, 0), cB + kstep, voffB); PG8_STAGE(PG8_SA(1, 0), cA + kstep, voffA); PG8_STAGE(PG8_SB(1, 1), cB + hstepB + kstep, voffB);
        PG8_WAIT_V(6); PG8_BAR;
    } else {
        PG8_STAGE(PG8_SB(0, 0), cB, voffB); PG8_STAGE(PG8_SA(0, 0), cA, voffA); PG8_STAGE(PG8_SB(0, 1), cB + hstepB, voffB); PG8_STAGE(PG8_SA(0, 1), cA + hstepA, voffA);
        if (wr == 1) PG8_BAR;
        PG8_WAIT_V(4); PG8_BAR;
        PG8_STAGE(PG8_SB(1, 0), cB + kstep, voffB); PG8_STAGE(PG8_SA(1, 0), cA + kstep, voffA); PG8_STAGE(PG8_SB(1, 1), cB + hstepB + kstep, voffB);
        PG8_WAIT_V(6); PG8_BAR;
    }
    for (;;) {
        const bool has_next = S.next(ui + 1, nxt);
        const char* nA = has_next ? (const char*)g.A + (size_t)nxt.pm * tstepA : cA; const char* nB = has_next ? (const char*)g.Bt + (size_t)nxt.pn * tstepB : cB;
#pragma nounroll
        for (int t = 0; t < nt; t += 2) {
            const bool last = (t == nt - 2);
            const char* a1 = cA + (size_t)(t + 1) * kstep;
            const char* a2 = last ? nA : cA + (size_t)(t + 2) * kstep; const char* b2 = last ? nB : cB + (size_t)(t + 2) * kstep;
            const char* a3 = a2 + kstep; const char* b3 = b2 + kstep;
            if (last && has_next) S.a_ready(nxt);
            if constexpr (SP2) {
            PG8_LDB(B0, 0, 0); PG8_LDB(B1, 0, 1); PG8_SCHED; PG8_LDA(At, 0, 0); PG8_STAGE(PG8_SA(1, 1), a1 + hstepA, voffA);
            PG8_WAIT_V(8); PG8_WAIT_L(0); PG8_BAR; PG8_MMA(0, 0, At, B0); PG8_MMA(0, 1, At, B1); PG8_BAR; PG8_SCHED;
            PG8_LDA(At, 0, 1); PG8_STAGE(PG8_SB(0, 0), b2, voffB); PG8_STAGE(PG8_SB(0, 1), b2 + hstepB, voffB); PG8_STAGE(PG8_SA(0, 0), a2, voffA);
            PG8_WAIT_V(8); PG8_WAIT_L(0); PG8_BAR; PG8_MMA(1, 0, At, B0); PG8_MMA(1, 1, At, B1); PG8_BAR; PG8_SCHED;
            PG8_LDB(B0, 1, 0); PG8_LDB(B1, 1, 1); PG8_SCHED; PG8_LDA(At, 1, 0); PG8_STAGE(PG8_SA(0, 1), a2 + hstepA, voffA);
            PG8_WAIT_V(8); PG8_WAIT_L(0); PG8_BAR; PG8_MMA(0, 0, At, B0); PG8_MMA(0, 1, At, B1); PG8_BAR; PG8_SCHED;
            PG8_LDA(At, 1, 1); PG8_STAGE(PG8_SB(1, 0), b3, voffB); PG8_STAGE(PG8_SB(1, 1), b3 + hstepB, voffB); PG8_STAGE(PG8_SA(1, 0), a3, voffA);
            PG8_WAIT_V(8); PG8_WAIT_L(0); PG8_BAR; PG8_MMA(1, 0, At, B0); PG8_MMA(1, 1, At, B1); PG8_BAR; PG8_SCHED;
            } else {
            PG8_LDB(B0, 0, 0); PG8_SCHED; PG8_LDA(At, 0, 0); PG8_STAGE(PG8_SA(1, 1), a1 + hstepA, voffA);
            PG8_WAIT_L(8); PG8_BAR; PG8_WAIT_L(0); PG8_MMA(0, 0, At, B0); PG8_BAR; PG8_SCHED;
            PG8_LDB(B1, 0, 1); PG8_STAGE(PG8_SB(0, 0), b2, voffB);
            PG8_BAR; PG8_WAIT_L(0); PG8_MMA(0, 1, At, B1); PG8_BAR;
            PG8_LDA(At, 0, 1); PG8_STAGE(PG8_SA(0, 0), a2, voffA);
            PG8_BAR; PG8_WAIT_L(0); PG8_MMA(1, 0, At, B0); PG8_BAR; PG8_SCHED;
            PG8_STAGE(PG8_SB(0, 1), b2 + hstepB, voffB);
            PG8_WAIT_V(6); PG8_BAR; PG8_MMA(1, 1, At, B1); PG8_BAR;
            PG8_LDB(B0, 1, 0); PG8_SCHED; PG8_LDA(At, 1, 0); PG8_STAGE(PG8_SA(0, 1), a2 + hstepA, voffA);
            PG8_WAIT_L(8); PG8_BAR; PG8_WAIT_L(0); PG8_MMA(0, 0, At, B0); PG8_BAR; PG8_SCHED;
            PG8_LDB(B1, 1, 1); PG8_STAGE(PG8_SB(1, 0), b3, voffB);
            PG8_BAR; PG8_WAIT_L(0); PG8_MMA(0, 1, At, B1); PG8_BAR;
            PG8_LDA(At, 1, 1); PG8_STAGE(PG8_SA(1, 0), a3, voffA);
            PG8_BAR; PG8_WAIT_L(0); PG8_MMA(1, 0, At, B0); PG8_BAR; PG8_SCHED;
            PG8_STAGE(PG8_SB(1, 1), b3 + hstepB, voffB);
            PG8_WAIT_V(6); PG8_BAR; PG8_MMA(1, 1, At, B1); PG8_BAR;
            }
        }
        if constexpr (ALIGN_EPI) { if (wr == 0) PG8_BAR; }
        if constexpr (!Epi::AFTER_DRAIN) { E(acc, cur, wr, wc, fr, fq); S.done(cur); }
        if (!has_next) break;
#pragma unroll
        for (int a = 0; a < 2; ++a)
#pragma unroll
            for (int b = 0; b < 2; ++b)
#pragma unroll
                for (int m = 0; m < 4; ++m)
#pragma unroll
                    for (int n = 0; n < 2; ++n) acc[a][b][m][n] = (f32x4){0.f, 0.f, 0.f, 0.f};
        cur = nxt; cA = nA; cB = nB; ++ui;
        if constexpr (ALIGN_EPI) { if (wr == 1) PG8_BAR; }
    }
    PG8_WAIT_V(0);
    if constexpr (!ALIGN_EPI) { if (wr == 0) PG8_BAR; }
    PG8_BAR;
    if constexpr (Epi::AFTER_DRAIN) { E.fused(acc, cur, wr, wc, fr, fq, lds, wid, lane); S.done(cur); }
#undef PG8_SA
#undef PG8_SB
#undef PG8_STAGE
#undef PG8_LDA
#undef PG8_LDB
#undef PG8_MMA
#undef PG8_WAIT_V
#undef PG8_WAIT_L
#undef PG8_BAR
#undef PG8_SCHED
}
}

using pg8::bf16_t; using pg8::bf16x8; using pg8::f32x4; using pg8::u32x4;
typedef float f32x16 __attribute__((ext_vector_type(16)));
typedef unsigned u32x2 __attribute__((ext_vector_type(2)));
typedef unsigned char uchar;
constexpr int NB = 4, SEQ = 8192, DM = 1024, LCTX = 256, DFF = 2816;
constexpr int TL = NB * SEQ;
constexpr int TC = NB * LCTX;
constexpr int MR = TL + TC;
constexpr int NMOD = 9 * DM;
constexpr int INW = 5792;
constexpr int P1W = 2816;
constexpr int QMW = 768, KVW = 1024;
constexpr float EPSN = 1e-6f;
constexpr float LOG2E = 1.4426950408889634f;
constexpr float MLA_C2 = 0.10206207261596575f * 1.4426950408889634f;
constexpr int LDS_BYTES = 147456;

constexpr size_t WS_XC = 0;
constexpr size_t WS_MOD = 4194304;
constexpr size_t WS_ROPE = 4718592;
constexpr size_t WS_W = 5242880;
constexpr size_t WE_UP1 = 0, WE_DN1 = 5767168, WE_UP2 = 8650752, WE_DN2 = 14417920, WE_IN = 17301504, WE_G = 20185088, WE_GR = 21233664, WE_GM = 22282240,
                 WE_UQ = 23330816, WE_UKV = 23625728, WE_RO = 23887872, WE_MO = 24936448, WE_WO = 25722880, WE_END = 26771456;
constexpr size_t WS_XN = WS_W + WE_END * 2;
constexpr size_t WS_A = WS_XN + (size_t)MR * DM * 2;
constexpr size_t WS_ST = WS_A + (size_t)MR * P1W * 2;
constexpr size_t WS_CT = WS_ST + 67108864;
constexpr size_t WS_QM = WS_CT + 2097152;
constexpr size_t WS_KVM = WS_QM + (size_t)MR * QMW * 2;
constexpr size_t WS_CTL = WS_KVM + (size_t)MR * KVW * 2;
constexpr size_t WS_END = WS_CTL + 16384;
static_assert(WS_END <= 536870912 && WS_CTL % 256 == 0, "workspace map exceeds 512 MiB");

struct KArgs { const float* in[24]; float* out; unsigned char* ws; int ph_lo, ph_hi; };

__device__ __forceinline__ int otid() { int t = threadIdx.x; asm volatile("" : "+v"(t)); return t; }
typedef float f32x2_t __attribute__((ext_vector_type(2))); typedef __bf16 bf16x2_t __attribute__((ext_vector_type(2)));
__device__ __forceinline__ unsigned pk2(float lo, float hi) { f32x2_t v = {lo, hi}; bf16x2_t b = __builtin_convertvector(v, bf16x2_t); return __builtin_bit_cast(unsigned, b); }
__device__ __forceinline__ float bf_lo(unsigned w) { return __uint_as_float(w << 16); }
__device__ __forceinline__ float bf_hi(unsigned w) { return __uint_as_float(w & 0xffff0000u); }
__device__ __forceinline__ float ex2(float x) { return __builtin_amdgcn_exp2f(x); }
__device__ __forceinline__ float sigm(float a) { return __builtin_amdgcn_rcpf(1.f + __builtin_amdgcn_exp2f(-a * LOG2E)); }
__device__ __forceinline__ float silu(float a) { return a * sigm(a); }
__device__ __forceinline__ float sigm2(float a2) { return __builtin_amdgcn_rcpf(1.f + __builtin_amdgcn_exp2f(-a2)); }
__device__ __forceinline__ int crow(int r, int hi) { return (r & 3) + 8 * (r >> 2) + 4 * hi; }
__device__ __forceinline__ int pos64(int kv) { const int p = kv >> 5, w = kv & 31; return 16 * (2 * p + (w >> 4)) + 8 * ((w >> 2) & 1) + (w & 3) + 4 * ((w >> 3) & 1); }
__device__ __forceinline__ float max_xor32(float v) { const auto rr = __builtin_amdgcn_permlane32_swap(__float_as_uint(v), __float_as_uint(v), false, false); return fmaxf(__uint_as_float(rr[0]), __uint_as_float(rr[1])); }
__device__ __forceinline__ float wave_sum(float v) {
#pragma unroll
    for (int o = 1; o < 64; o <<= 1) v += __shfl_xor(v, o);
    return v;
}
__device__ __forceinline__ bf16x8 pack8(float a0, float a1, float a2, float a3, float a4, float a5, float a6, float a7) {
    u32x4 w; w.x = pk2(a0, a1); w.y = pk2(a2, a3); w.z = pk2(a4, a5); w.w = pk2(a6, a7); return __builtin_bit_cast(bf16x8, w);
}
#define MFMA32(a, b, c) __builtin_amdgcn_mfma_f32_32x32x16_bf16((a), (b), (c), 0, 0, 0)

struct EpiUp {
    static constexpr bool PERM = true, AFTER_DRAIN = false;
    bf16_t* H;
    __device__ __forceinline__ void operator()(const f32x4 (&acc)[2][2][4][2], const pg8::Unit& u, int wr, int wc, int fr, int fq) const {
        const int row0 = u.pm * 256 + wr * 64 + fr, col = u.pn * 128 + wc * 32 + 8 * fq;
#pragma unroll
        for (int ai = 0; ai < 2; ++ai)
#pragma unroll
            for (int m = 0; m < 4; ++m) {
                const f32x4 a0 = acc[ai][0][m][0], a1 = acc[ai][0][m][1], b0 = acc[ai][1][m][0], b1 = acc[ai][1][m][1];
                u32x4 w;
#define SWG(a, b) ((a) * (b) * __builtin_amdgcn_rcpf(1.f + __builtin_amdgcn_exp2f(-(a))))
                w.x = pk2(SWG(a0[0], b0[0]), SWG(a0[1], b0[1])); w.y = pk2(SWG(a0[2], b0[2]), SWG(a0[3], b0[3]));
                w.z = pk2(SWG(a1[0], b1[0]), SWG(a1[1], b1[1])); w.w = pk2(SWG(a1[2], b1[2]), SWG(a1[3], b1[3]));
#undef SWG
                *(u32x4*)(H + (size_t)(row0 + ai * 128 + m * 16) * DFF + col) = w;
            }
    }
};
struct EpiRes {
    static constexpr bool PERM = false, AFTER_DRAIN = false;
    const float* bl; const float* bc; float* ol; float* oc; const float* gate; float gs;
    __device__ __forceinline__ void operator()(const f32x4 (&acc)[2][2][4][2], const pg8::Unit& u, int wr, int wc, int fr, int fq) const {
        const bool lat = u.pm < 128; const int ms = lat ? (u.pm >> 5) : 4;
        const size_t toff = (size_t)(lat ? u.pm : u.pm - 128) * 256 * DM;
        const float* base = (lat ? bl : bc) + toff; float* out = (lat ? ol : oc) + toff;
        const float* g = gate + ms * NMOD; const int col0 = u.pn * 256 + wc * 32 + 4 * fq;
#pragma unroll
        for (int bj = 0; bj < 2; ++bj)
#pragma unroll
            for (int n = 0; n < 2; ++n) {
                const f32x4 gv = *(const f32x4*)(g + col0 + bj * 128 + n * 16) * gs;
                f32x4 b[8];
#pragma unroll
                for (int i = 0; i < 8; ++i) b[i] = *(const f32x4*)(base + (size_t)((i >> 2) * 128 + wr * 64 + (i & 3) * 16 + fr) * DM + col0 + bj * 128 + n * 16);
#pragma unroll
                for (int i = 0; i < 8; ++i) *(f32x4*)(out + (size_t)((i >> 2) * 128 + wr * 64 + (i & 3) * 16 + fr) * DM + col0 + bj * 128 + n * 16) = b[i] + gv * acc[i >> 2][bj][i & 3][n];
                asm volatile("" ::: "memory");
            }
    }
};
template <int MODE> struct EpiBf {
    static constexpr bool PERM = true, AFTER_DRAIN = false;
    bf16_t* O; int ldc; const bf16_t* X; int ldx;
    __device__ __forceinline__ void operator()(const f32x4 (&acc)[2][2][4][2], const pg8::Unit& u, int wr, int wc, int fr, int fq) const {
        const int row0 = u.pm * 256 + wr * 64 + fr, col0 = u.pn * 256 + wc * 32 + 8 * fq;
#pragma unroll
        for (int ai = 0; ai < 2; ++ai)
#pragma unroll
            for (int mh = 0; mh < 2; ++mh) {
                u32x4 cw[4], xw[4];
                if (MODE != 0) {
#pragma unroll
                    for (int i = 0; i < 4; ++i) { const size_t row = (size_t)(row0 + ai * 128 + (2 * mh + (i >> 1)) * 16); const int co = col0 + (i & 1) * 128;
                        cw[i] = *(const u32x4*)(O + row * ldc + co); if (MODE >= 3) xw[i] = *(const u32x4*)(X + row * ldx + co); }
                }
#pragma unroll
                for (int i = 0; i < 4; ++i) {
                    const int m = 2 * mh + (i >> 1), bj = i & 1;
                    bf16_t* p = O + (size_t)(row0 + ai * 128 + m * 16) * ldc + col0 + bj * 128;
                    const f32x4 v0 = acc[ai][bj][m][0], v1 = acc[ai][bj][m][1];
                    float v[8] = {v0[0], v0[1], v0[2], v0[3], v1[0], v1[1], v1[2], v1[3]};
                    if (MODE != 0) {
                        float c[8] = {bf_lo(cw[i].x), bf_hi(cw[i].x), bf_lo(cw[i].y), bf_hi(cw[i].y), bf_lo(cw[i].z), bf_hi(cw[i].z), bf_lo(cw[i].w), bf_hi(cw[i].w)};
                        if (MODE == 1) {
#pragma unroll
                            for (int e = 0; e < 8; ++e) v[e] = v[e] * sigm2(v[e]) * c[e];
                        } else if (MODE == 2) {
#pragma unroll
                            for (int e = 0; e < 8; ++e) v[e] = sigm2(v[e]) * c[e];
                        } else {
                            float x[8] = {bf_lo(xw[i].x), bf_hi(xw[i].x), bf_lo(xw[i].y), bf_hi(xw[i].y), bf_lo(xw[i].z), bf_hi(xw[i].z), bf_lo(xw[i].w), bf_hi(xw[i].w)};
#pragma unroll
                            for (int e = 0; e < 8; ++e) v[e] = (MODE == 4 ? 0.f : c[e]) + sigm2(v[e]) * x[e];
                        }
                    }
                    u32x4 w; w.x = pk2(v[0], v[1]); w.y = pk2(v[2], v[3]); w.z = pk2(v[4], v[5]); w.w = pk2(v[6], v[7]);
                    *(u32x4*)p = w;
                }
                asm volatile("" ::: "memory");
            }
    }
};
template <bool IS_UQ> struct EpiRope {
    static constexpr bool PERM = true, AFTER_DRAIN = false;
    bf16_t* O; const float* rt16c; const float* rt16s; const float* rt8c; const float* rt8s;
    __device__ __forceinline__ void operator()(const f32x4 (&acc)[2][2][4][2], const pg8::Unit& u, int wr, int wc, int fr, int fq) const {
        constexpr int LDC = IS_UQ ? QMW : P1W;
#pragma unroll
        for (int ai = 0; ai < 2; ++ai)
#pragma unroll
            for (int m = 0; m < 4; ++m) {
                const int row = u.pm * 256 + ai * 128 + wr * 64 + m * 16 + fr;
                const bool lat = row < TL; const int t = row & (SEQ - 1), pr = t >> 6, pc = t & 63;
#pragma unroll
                for (int bj = 0; bj < 2; ++bj) {
                    const int cg = (u.pn * 256 + bj * 128 + wc * 32) >> 5;
                    f32x4 v0 = acc[ai][bj][m][0], v1 = acc[ai][bj][m][1];
                    bool r16 = false, r8 = false; float sc = 1.f;
                    if (IS_UQ) { r8 = (cg % 3) == 2; sc = MLA_C2; }
                    else { r16 = cg < 32; r8 = cg == 84; if (cg >= 16 && cg < 32) sc = 0.125f; }
                    if (r16 && lat) {
                        const int pos = (cg & 1) ? pc : pr;
                        const f32x4 cs = *(const f32x4*)(rt16c + pos * 16 + 4 * fq), sn = *(const f32x4*)(rt16s + pos * 16 + 4 * fq);
                        const f32x4 o0 = v0 * cs - v1 * sn, o1 = v1 * cs + v0 * sn; v0 = o0; v1 = o1;
                    }
                    if (r8 && lat) {
                        const int pos = (fq >> 1) ? pc : pr;
                        const f32x4 cs = *(const f32x4*)(rt8c + pos * 8 + 4 * (fq & 1)), sn = *(const f32x4*)(rt8s + pos * 8 + 4 * (fq & 1));
                        const f32x4 o0 = v0 * cs - v1 * sn, o1 = v1 * cs + v0 * sn; v0 = o0; v1 = o1;
                    }
                    v0 = v0 * sc; v1 = v1 * sc;
                    u32x4 w; w.x = pk2(v0[0], v0[1]); w.y = pk2(v0[2], v0[3]); w.z = pk2(v1[0], v1[1]); w.w = pk2(v1[2], v1[3]);
                    *(u32x4*)(O + (size_t)row * LDC + cg * 32 + 8 * fq) = w;
                }
            }
    }
};


struct FinRes { const float* base; float* out; const float* gate; float gs;
    __device__ __forceinline__ void operator()(int r, int c, f32x4 s0, f32x4 s1) const {
        const size_t off = (size_t)r * DM + c;
        const f32x4 g0 = *(const f32x4*)(gate + c) * gs, g1 = *(const f32x4*)(gate + c + 4) * gs;
        const f32x4 x0 = *(const f32x4*)(base + off), x1 = *(const f32x4*)(base + off + 4);
        *(f32x4*)(out + off) = x0 + g0 * s0; *(f32x4*)(out + off + 4) = x1 + g1 * s1; } };
template <int MODE> struct FinBf { bf16_t* O; int ldc; const bf16_t* X; int ldx;
    __device__ __forceinline__ void operator()(int r, int c, f32x4 s0, f32x4 s1) const {
        bf16_t* p = O + (size_t)r * ldc + c;
        float v[8] = {s0[0], s0[1], s0[2], s0[3], s1[0], s1[1], s1[2], s1[3]};
        if (MODE != 0) {
            const u32x4 cw = *(const u32x4*)p;
            float cc[8] = {bf_lo(cw.x), bf_hi(cw.x), bf_lo(cw.y), bf_hi(cw.y), bf_lo(cw.z), bf_hi(cw.z), bf_lo(cw.w), bf_hi(cw.w)};
            if (MODE == 1) {
#pragma unroll
                for (int i = 0; i < 8; ++i) v[i] = v[i] * sigm2(v[i]) * cc[i];
            } else if (MODE == 2) {
#pragma unroll
                for (int i = 0; i < 8; ++i) v[i] = sigm2(v[i]) * cc[i];
            } else {
                const u32x4 xw = *(const u32x4*)(X + (size_t)r * ldx + c);
                float x[8] = {bf_lo(xw.x), bf_hi(xw.x), bf_lo(xw.y), bf_hi(xw.y), bf_lo(xw.z), bf_hi(xw.z), bf_lo(xw.w), bf_hi(xw.w)};
#pragma unroll
                for (int i = 0; i < 8; ++i) v[i] = cc[i] + sigm2(v[i]) * x[i];
            }
        }
        u32x4 w; w.x = pk2(v[0], v[1]); w.y = pk2(v[2], v[3]); w.z = pk2(v[4], v[5]); w.w = pk2(v[6], v[7]);
        *(u32x4*)p = w; } };
template <class Fin> __device__ __forceinline__ void ctx_gemm(const bf16_t* A, int lda, const bf16_t* Bt, int K, const Fin& fin, uchar* lds) {
    const int tid = otid(), lane = tid & 63, wave = tid >> 6, l32 = lane & 31, hi = lane >> 5;
    float* red = (float*)lds;
    const int kw = K >> 3, nst = kw >> 4;
    for (int id = blockIdx.x; id < 256; id += gridDim.x) {
        const int tr = id >> 3, tc = id & 7;
        const bf16_t* ap = A + (size_t)(tr * 32 + l32) * lda + wave * kw + 8 * hi;
        const bf16_t* bp = Bt + (size_t)(tc * 128 + l32) * K + wave * kw + 8 * hi;
        f32x16 acc0 = {}, acc1 = {}, acc2 = {}, acc3 = {};
#pragma unroll 8
        for (int s = 0; s < nst; ++s) {
            const bf16x8 af = *(const bf16x8*)(ap + 16 * s);
            const bf16x8 b0 = *(const bf16x8*)(bp + 16 * s), b1 = *(const bf16x8*)(bp + (size_t)32 * K + 16 * s), b2 = *(const bf16x8*)(bp + (size_t)64 * K + 16 * s), b3 = *(const bf16x8*)(bp + (size_t)96 * K + 16 * s);
            acc0 = MFMA32(af, b0, acc0); acc1 = MFMA32(af, b1, acc1); acc2 = MFMA32(af, b2, acc2); acc3 = MFMA32(af, b3, acc3);
        }
        float* rw = red + wave * 4096 + l32;
#pragma unroll
        for (int r = 0; r < 16; ++r) { float* q = rw + crow(r, hi) * 128; q[0] = acc0[r]; q[32] = acc1[r]; q[64] = acc2[r]; q[96] = acc3[r]; }
        __syncthreads();
        const int row = tid >> 4, c8 = (tid & 15) * 8;
        f32x4 s0 = {}, s1 = {};
#pragma unroll
        for (int w = 0; w < 8; ++w) { s0 += *(const f32x4*)(red + w * 4096 + row * 128 + c8); s1 += *(const f32x4*)(red + w * 4096 + row * 128 + c8 + 4); }
        fin(tr * 32 + row, tc * 128 + c8, s0, s1);
        __syncthreads();
    }
}
__device__ __forceinline__ void sincos_d(double x, double& s, double& c) {
    const double TWO_PI = 6.283185307179586476925;
    const double k = rint(x / TWO_PI); const double r = x - k * TWO_PI; const double r2 = r * r;
    double ss = 1.0, cc = 1.0;
#pragma unroll
    for (int n = 15; n >= 1; --n) { ss = 1.0 - r2 / (double)((2 * n) * (2 * n + 1)) * ss; cc = 1.0 - r2 / (double)((2 * n - 1) * (2 * n)) * cc; }
    s = r * ss; c = cc;
}
__device__ __forceinline__ void phase_mods(const KArgs& a, uchar* lds) {
    const int tid = otid(), lane = tid & 63, wave = tid >> 6;
    float* sm = (float*)lds; float* red = sm + 5 * 1024;
    for (int idx = tid; idx < 5 * 1024; idx += 512) { const int ms = idx >> 10, k = idx & 1023; const float c = ms < 4 ? a.in[1][ms * 1024 + k] : a.in[3][k]; sm[idx] = c / (1.f + expf(-c)); }
    __syncthreads();
    float* mod = (float*)(a.ws + WS_MOD);
    for (int item = blockIdx.x; item < 288; item += gridDim.x) {
        const int l = item / 144, j = (item % 144) * 64 + lane;
        const float* w = a.in[4] + (size_t)l * 1024 * NMOD + j;
        float acc[5] = {0.f, 0.f, 0.f, 0.f, 0.f};
#pragma unroll 32
        for (int kk = 0; kk < 128; ++kk) { const int k = wave * 128 + kk; const float wv = w[(size_t)k * NMOD];
#pragma unroll
            for (int ms = 0; ms < 5; ++ms) acc[ms] += sm[ms * 1024 + k] * wv; }
#pragma unroll
        for (int ms = 0; ms < 5; ++ms) red[(wave * 5 + ms) * 64 + lane] = acc[ms];
        __syncthreads();
        if (wave == 0) {
#pragma unroll
            for (int ms = 0; ms < 5; ++ms) { float s = 0.f;
#pragma unroll
                for (int w8 = 0; w8 < 8; ++w8) s += red[(w8 * 5 + ms) * 64 + lane];
                mod[(size_t)(l * 5 + ms) * NMOD + j] = s + a.in[5][l * NMOD + j]; }
        }
        __syncthreads();
    }
    float* rt = (float*)(a.ws + WS_ROPE);
    for (int idx = blockIdx.x * 512 + tid; idx < 128 * 24; idx += gridDim.x * 512) {
        const int pos = idx / 24, f = idx % 24;
        const float invf = f < 16 ? exp2f(-(float)f * (13.287712379549449f / 16.f)) : exp2f(-(float)(f - 16) * (13.287712379549449f / 8.f));
        const float ang = (float)pos * invf; double s, c; sincos_d((double)ang, s, c);
        if (f < 16) { rt[pos * 16 + f] = (float)c; rt[2048 + pos * 16 + f] = (float)s; }
        else { rt[4096 + pos * 8 + (f - 16)] = (float)c; rt[5120 + pos * 8 + (f - 16)] = (float)s; }
    }
}
__device__ __forceinline__ int rope16_perm(int p) { return 32 * (p >> 5) + 16 * ((p >> 2) & 1) + 4 * ((p >> 3) & 3) + (p & 3); }
__device__ __forceinline__ int rope8_perm(int p) { const int fq = p >> 3; return 16 * (fq >> 1) + 8 * ((p >> 2) & 1) + 4 * (fq & 1) + (p & 3); }
template <int MODE> __device__ __forceinline__ void conv_item(const float* W, const float* W2, int Nsrc, int N, int Kd, int coff, bf16_t* WT, float* scr, int item, int lane, float wscale = 1.f) {
    const int nblk = N / 32, kb = item / nblk, nb = item % nblk, k0 = 64 * kb, n0 = 32 * nb;
    const int j = n0 + (lane & 31);
    const float* Wp = W; int sc;
    if (MODE == 0) sc = coff + j;
    else if (MODE == 1) { const int jj = j & 255; Wp = jj < 128 ? W : W2; sc = 128 * (j >> 8) + (jj & 127); }
    else if (MODE == 2) {
        if (j < 1024) sc = (j >> 9) * 512 + ((j >> 6) & 7) * 64 + rope16_perm(j & 63);
        else if (j < 2048) sc = j;
        else if (j < 2432) sc = 3072 + (j - 2048);
        else if (j < 2688) sc = 3456 + (j - 2432);
        else if (j < 2720) sc = 3712 + rope8_perm(j - 2688);
        else sc = -1;
    } else if (MODE == 3) { const int hd = j / 96, d = j % 96; sc = hd * 96 + (d < 64 ? d : 64 + rope8_perm(d - 64)); }
    else if (MODE == 4) { if (j < 512) sc = (j >> 6) * 128 + (j & 63); else { const int jj = j - 512; sc = (jj >> 6) * 128 + 64 + (jj & 63); } }
    else sc = j;
#pragma unroll
    for (int i = 0; i < 32; ++i) {
        const int kk = 2 * i + (lane >> 5); int ks = k0 + kk;
        if (MODE == 5) { const int hd = ks / 96, d = ks % 96; ks = d < 64 ? hd * 64 + d : -1; }
        float v = 0.f; if (sc >= 0 && ks >= 0) v = Wp[(size_t)ks * Nsrc + sc];
        if (MODE == 0) v *= wscale;
        if (MODE == 1) v *= ((j & 255) < 128) ? LOG2E : (1.f / LOG2E);
        scr[kk * 33 + (lane & 31)] = v;
    }
    asm volatile("s_waitcnt lgkmcnt(0)" ::: "memory");
    const int c = lane & 7;
#pragma unroll
    for (int q = 0; q < 4; ++q) { const int n = (lane >> 3) + 8 * q; const float* s = scr + (8 * c) * 33 + n;
        u32x4 o; o.x = pk2(s[0], s[33]); o.y = pk2(s[66], s[99]); o.z = pk2(s[132], s[165]); o.w = pk2(s[198], s[231]);
        *(u32x4*)(WT + (size_t)(n0 + n) * Kd + k0 + 8 * c) = o; }
    asm volatile("s_waitcnt lgkmcnt(0)" ::: "memory");
}
__device__ __forceinline__ void phase_conv(const KArgs& a, uchar* lds, int l, int mode = 0, int blk0 = 0) {
    const int tid = otid(), lane = tid & 63, wave = tid >> 6;
    float* scr = (float*)(lds + wave * 16384);
    bf16_t* WB = (bf16_t*)(a.ws + WS_W);
    const int gw = ((int)blockIdx.x - blk0) * 8 + wave, NGW = ((int)gridDim.x - blk0) * 8;
    const float* f1w1 = a.in[6] + (size_t)l * DM * DFF; const float* f1w3 = a.in[7] + (size_t)l * DM * DFF; const float* f1w2 = a.in[8] + (size_t)l * DFF * DM;
    const float* f2w1 = a.in[9] + (size_t)l * DM * DFF; const float* f2w3 = a.in[10] + (size_t)l * DM * DFF; const float* f2w2 = a.in[11] + (size_t)l * DFF * DM;
    const float* win = a.in[12] + (size_t)l * DM * INW;
    const float* wuq = a.in[18] + (size_t)l * 384 * 768; const float* wukv = a.in[19] + (size_t)l * 256 * 1024;
    const float* wro = a.in[20] + (size_t)l * 1024 * 1024; const float* wmo = a.in[21] + (size_t)l * 512 * 1024; const float* wo = a.in[22] + (size_t)l * 1024 * 1024;
    constexpr int I_UP = 176 * 16, I_DN = 32 * 44, I_IN = 88 * 16, I_G = 32 * 16, I_UQ = 24 * 6, I_UKV = 32 * 4, I_MO = 32 * 8;
    constexpr int NIT = 2 * I_UP + 2 * I_DN + I_IN + 3 * I_G + I_UQ + I_UKV + I_G + I_MO + I_G;
    for (int it = gw; it < NIT; it += NGW) {
        int r = it;
        { const bool ffn2 = it >= I_UP + I_DN && it < 2 * I_UP + 2 * I_DN; if ((mode == 1 && ffn2) || (mode == 2 && !ffn2)) continue; }
        if (r < I_UP) { conv_item<1>(f1w1, f1w3, DFF, 5632, 1024, 0, WB + WE_UP1, scr, r, lane); continue; } r -= I_UP;
        if (r < I_DN) { conv_item<0>(f1w2, nullptr, DM, 1024, DFF, 0, WB + WE_DN1, scr, r, lane); continue; } r -= I_DN;
        if (r < I_UP) { conv_item<1>(f2w1, f2w3, DFF, 5632, 1024, 0, WB + WE_UP2, scr, r, lane); continue; } r -= I_UP;
        if (r < I_DN) { conv_item<0>(f2w2, nullptr, DM, 1024, DFF, 0, WB + WE_DN2, scr, r, lane); continue; } r -= I_DN;
        if (r < I_IN) { conv_item<2>(win, nullptr, INW, P1W, 1024, 0, WB + WE_IN, scr, r, lane); continue; } r -= I_IN;
        if (r < I_G) { conv_item<0>(win, nullptr, INW, 1024, 1024, 2048, WB + WE_G, scr, r, lane, LOG2E); continue; } r -= I_G;
        if (r < I_G) { conv_item<0>(win, nullptr, INW, 1024, 1024, 3744, WB + WE_GR, scr, r, lane, LOG2E); continue; } r -= I_G;
        if (r < I_G) { conv_item<0>(win, nullptr, INW, 1024, 1024, 4768, WB + WE_GM, scr, r, lane, LOG2E); continue; } r -= I_G;
        if (r < I_UQ) { conv_item<3>(wuq, nullptr, 768, 768, 384, 0, WB + WE_UQ, scr, r, lane); continue; } r -= I_UQ;
        if (r < I_UKV) { conv_item<4>(wukv, nullptr, 1024, 1024, 256, 0, WB + WE_UKV, scr, r, lane); continue; } r -= I_UKV;
        if (r < I_G) { conv_item<0>(wro, nullptr, 1024, 1024, 1024, 0, WB + WE_RO, scr, r, lane); continue; } r -= I_G;
        if (r < I_MO) { conv_item<0>(wmo, nullptr, 1024, 1024, 512, 0, WB + WE_MO, scr, r, lane); continue; } r -= I_MO;
        conv_item<0>(wo, nullptr, 1024, 1024, 1024, 0, WB + WE_WO, scr, r, lane);
    }
}
__device__ __forceinline__ void phase_norm(const float* xl, const float* xc, const float* mod, int shoff, bf16_t* XN, int M = MR) {
    const int tid = otid(), lane = tid & 63, gw = blockIdx.x * 8 + (tid >> 6), NGW = gridDim.x * 8;
    for (int row0 = gw; row0 < M; row0 += 2 * NGW) {
        const int row1 = row0 + NGW; const bool has1 = row1 < M;
        const float* src0 = row0 < TL ? xl + (size_t)row0 * DM : xc + (size_t)(row0 - TL) * DM;
        const float* src1 = has1 ? (row1 < TL ? xl + (size_t)row1 * DM : xc + (size_t)(row1 - TL) * DM) : src0;
        f32x4 v0[4], v1[4]; float s0 = 0.f, s1 = 0.f;
#pragma unroll
        for (int j = 0; j < 4; ++j) { v0[j] = *(const f32x4*)(src0 + 4 * lane + 256 * j); v1[j] = *(const f32x4*)(src1 + 4 * lane + 256 * j); }
#pragma unroll
        for (int j = 0; j < 4; ++j) { s0 += (v0[j].x * v0[j].x + v0[j].y * v0[j].y) + (v0[j].z * v0[j].z + v0[j].w * v0[j].w); s1 += (v1[j].x * v1[j].x + v1[j].y * v1[j].y) + (v1[j].z * v1[j].z + v1[j].w * v1[j].w); }
        const float r0 = 1.f / sqrtf(wave_sum(s0) * (1.f / DM) + EPSN), r1 = 1.f / sqrtf(wave_sum(s1) * (1.f / DM) + EPSN);
        const float* mp0 = mod + (row0 < TL ? (row0 >> 13) : 4) * NMOD + shoff; const float* mp1 = mod + (row1 < TL ? (row1 >> 13) : 4) * NMOD + shoff;
#pragma unroll
        for (int j = 0; j < 4; ++j) {
            const f32x4 sh = *(const f32x4*)(mp0 + 4 * lane + 256 * j), sc = *(const f32x4*)(mp0 + DM + 4 * lane + 256 * j);
            const f32x4 o = v0[j] * r0 * (sc + 1.f) + sh; u32x2 w; w.x = pk2(o.x, o.y); w.y = pk2(o.z, o.w);
            *(u32x2*)(XN + (size_t)row0 * DM + 4 * lane + 256 * j) = w;
        }
        if (has1) {
#pragma unroll
            for (int j = 0; j < 4; ++j) {
                const f32x4 sh = *(const f32x4*)(mp1 + 4 * lane + 256 * j), sc = *(const f32x4*)(mp1 + DM + 4 * lane + 256 * j);
                const f32x4 o = v1[j] * r1 * (sc + 1.f) + sh; u32x2 w; w.x = pk2(o.x, o.y); w.y = pk2(o.z, o.w);
                *(u32x2*)(XN + (size_t)row1 * DM + 4 * lane + 256 * j) = w;
            }
        }
    }
}
__device__ __forceinline__ void phase_final_norm(float* x, const float* gain) {
    const int tid = otid(), lane = tid & 63, gw = blockIdx.x * 8 + (tid >> 6), NGW = gridDim.x * 8;
    for (int row0 = gw; row0 < TL; row0 += 2 * NGW) {
        const int row1 = row0 + NGW; const bool has1 = row1 < TL;
        float* p0 = x + (size_t)row0 * DM; float* p1 = has1 ? x + (size_t)row1 * DM : p0;
        f32x4 v0[4], v1[4]; float s0 = 0.f, s1 = 0.f;
#pragma unroll
        for (int j = 0; j < 4; ++j) { v0[j] = *(const f32x4*)(p0 + 4 * lane + 256 * j); v1[j] = *(const f32x4*)(p1 + 4 * lane + 256 * j); }
#pragma unroll
        for (int j = 0; j < 4; ++j) { s0 += (v0[j].x * v0[j].x + v0[j].y * v0[j].y) + (v0[j].z * v0[j].z + v0[j].w * v0[j].w); s1 += (v1[j].x * v1[j].x + v1[j].y * v1[j].y) + (v1[j].z * v1[j].z + v1[j].w * v1[j].w); }
        const float r0 = 1.f / sqrtf(wave_sum(s0) * (1.f / DM) + EPSN), r1 = 1.f / sqrtf(wave_sum(s1) * (1.f / DM) + EPSN);
#pragma unroll
        for (int j = 0; j < 4; ++j) { const f32x4 g = *(const f32x4*)(gain + 4 * lane + 256 * j); *(f32x4*)(p0 + 4 * lane + 256 * j) = v0[j] * r0 * g; if (has1) *(f32x4*)(p1 + 4 * lane + 256 * j) = v1[j] * r1 * g; }
    }
}
__device__ __forceinline__ void phase_mla_prep(bf16_t* P1, const float* qn, const float* kvn) {
    const int tid = otid(), lane = tid & 63, gw = blockIdx.x * 8 + (tid >> 6), NGW = gridDim.x * 8;
    f32x4 gq0 = {}, gq1 = {}, gk0 = {}, gk1 = {};
    if (lane < 48) { gq0 = *(const f32x4*)(qn + 8 * lane); gq1 = *(const f32x4*)(qn + 8 * lane + 4); }
    if (lane < 32) { gk0 = *(const f32x4*)(kvn + 8 * lane); gk1 = *(const f32x4*)(kvn + 8 * lane + 4); }
    for (int rowb = gw; rowb < MR; rowb += 4 * NGW) {
        u32x4 wq[4], wk[4];
#pragma unroll
        for (int i = 0; i < 4; ++i) { const int row = rowb + i * NGW; wq[i] = (u32x4){0u, 0u, 0u, 0u}; wk[i] = wq[i];
            if (row < MR) { if (lane < 48) wq[i] = *(const u32x4*)(P1 + (size_t)row * P1W + 2048 + 8 * lane); if (lane < 32) wk[i] = *(const u32x4*)(P1 + (size_t)row * P1W + 2432 + 8 * lane); } }
#pragma unroll
        for (int i = 0; i < 4; ++i) { const int row = rowb + i * NGW;
            float q[8] = {bf_lo(wq[i].x), bf_hi(wq[i].x), bf_lo(wq[i].y), bf_hi(wq[i].y), bf_lo(wq[i].z), bf_hi(wq[i].z), bf_lo(wq[i].w), bf_hi(wq[i].w)};
            float k[8] = {bf_lo(wk[i].x), bf_hi(wk[i].x), bf_lo(wk[i].y), bf_hi(wk[i].y), bf_lo(wk[i].z), bf_hi(wk[i].z), bf_lo(wk[i].w), bf_hi(wk[i].w)};
            float sq = 0.f, sk = 0.f;
#pragma unroll
            for (int e = 0; e < 8; ++e) { sq += q[e] * q[e]; sk += k[e] * k[e]; }
            const float rq = 1.f / sqrtf(wave_sum(sq) * (1.f / 384.f) + EPSN), rk = 1.f / sqrtf(wave_sum(sk) * (1.f / 256.f) + EPSN);
            if (row < MR) {
                if (lane < 48) { u32x4 o; o.x = pk2(q[0] * rq * gq0.x, q[1] * rq * gq0.y); o.y = pk2(q[2] * rq * gq0.z, q[3] * rq * gq0.w); o.z = pk2(q[4] * rq * gq1.x, q[5] * rq * gq1.y); o.w = pk2(q[6] * rq * gq1.z, q[7] * rq * gq1.w);
                    *(u32x4*)(P1 + (size_t)row * P1W + 2048 + 8 * lane) = o; }
                if (lane < 32) { u32x4 o; o.x = pk2(k[0] * rk * gk0.x, k[1] * rk * gk0.y); o.y = pk2(k[2] * rk * gk0.z, k[3] * rk * gk0.w); o.z = pk2(k[4] * rk * gk1.x, k[5] * rk * gk1.y); o.w = pk2(k[6] * rk * gk1.z, k[7] * rk * gk1.w);
                    *(u32x4*)(P1 + (size_t)row * P1W + 2432 + 8 * lane) = o; }
            }
        }
    }
}

constexpr int TS = 272;
__device__ __forceinline__ void tstore_pair(uchar* T, int stride, int posb, int c8, u32x4 r0, u32x4 r1, int sw = 0) {
    uchar* p = T + (size_t)(8 * c8) * stride + posb * 2; (void)sw;
    *(unsigned*)(p + 0 * stride) = (r0.x & 0xffffu) | (r1.x << 16); *(unsigned*)(p + 1 * stride) = (r0.x >> 16) | (r1.x & 0xffff0000u);
    *(unsigned*)(p + 2 * stride) = (r0.y & 0xffffu) | (r1.y << 16); *(unsigned*)(p + 3 * stride) = (r0.y >> 16) | (r1.y & 0xffff0000u);
    *(unsigned*)(p + 4 * stride) = (r0.z & 0xffffu) | (r1.z << 16); *(unsigned*)(p + 5 * stride) = (r0.z >> 16) | (r1.z & 0xffff0000u);
    *(unsigned*)(p + 6 * stride) = (r0.w & 0xffffu) | (r1.w << 16); *(unsigned*)(p + 7 * stride) = (r0.w >> 16) | (r1.w & 0xffff0000u);
}
__device__ __forceinline__ u32x4 scale8(u32x4 w, float s) {
    u32x4 o; o.x = pk2(bf_lo(w.x) * s, bf_hi(w.x) * s); o.y = pk2(bf_lo(w.y) * s, bf_hi(w.y) * s); o.z = pk2(bf_lo(w.z) * s, bf_hi(w.z) * s); o.w = pk2(bf_lo(w.w) * s, bf_hi(w.w) * s); return o;
}
__device__ __forceinline__ void phase_r1(const bf16_t* P1, bf16_t* ST, bf16_t* CT, const float* dfw, const float* dbw, uchar* lds) {
    const int tid = otid(), lane = tid & 63, wave = tid >> 6, l32 = lane & 31, hi = lane >> 5;
    uchar* Tv = lds; uchar* Tkf = lds + 128 * TS; uchar* Tkb = Tkf + 64 * TS;
    const int kpa = tid >> 3, kc8 = tid & 7, j0 = 2 * kpa;
    u32x4 rv[4], rk[2];
#define R1_ROWS(u) ((u) < 2048 ? ((u) >> 9) * SEQ + ((u) & 63) * 128 : TL + (((u) - 2048) >> 4) * LCTX + (((u) - 2048) & 1) * 128)
#define R1_HEAD(u) ((u) < 2048 ? (((u) >> 6) & 7) : ((((u) - 2048) >> 1) & 7))
#define R1_LOAD(u) do { const int rows_ = R1_ROWS(u), h_ = R1_HEAD(u); const bf16_t* kp_ = P1 + (size_t)rows_ * P1W + 512 + h_ * 64; const bf16_t* vp_ = P1 + (size_t)rows_ * P1W + 1024 + h_ * 128; \
        _Pragma("unroll") for (int i = 0; i < 2; ++i) { const int task = tid + 512 * i, pa = task >> 4, c8 = task & 15; \
            rv[2 * i] = *(const u32x4*)(vp_ + (size_t)(2 * pa) * P1W + 8 * c8); rv[2 * i + 1] = *(const u32x4*)(vp_ + (size_t)(2 * pa + 1) * P1W + 8 * c8); } \
        rk[0] = *(const u32x4*)(kp_ + (size_t)j0 * P1W + 8 * kc8); rk[1] = *(const u32x4*)(kp_ + (size_t)(j0 + 1) * P1W + 8 * kc8); } while (0)
    int u = blockIdx.x;
    if (u < 2112) R1_LOAD(u);
    for (; u < 2112; u += gridDim.x) {
        int b, h; bf16_t* dstf; bf16_t* dstb;
        if (u < 2048) { b = u >> 9; h = (u >> 6) & 7; const int n = u & 63;
            dstf = ST + ((size_t)((0 * 4 + b) * 8 + h) * 64 + n) * 8192; dstb = ST + ((size_t)((1 * 4 + b) * 8 + h) * 64 + n) * 8192; }
        else { const int uc = u - 2048; b = uc >> 4; h = (uc >> 1) & 7; const int nc = uc & 1;
            dstf = CT + ((size_t)((0 * 4 + b) * 8 + h) * 2 + nc) * 8192; dstb = CT + ((size_t)((1 * 4 + b) * 8 + h) * 2 + nc) * 8192; }
        const float lgf = -expf(dfw[h]) * LOG2E, lgb = -expf(dbw[h]) * LOG2E;
#pragma unroll
        for (int i = 0; i < 2; ++i) { const int task = tid + 512 * i, pa = task >> 4, c8 = task & 15; tstore_pair(Tv, TS, (2 * pa & 64) + pos64(2 * pa & 63), c8, rv[2 * i], rv[2 * i + 1], c8); }
        { const int posb = (j0 & 64) + pos64(j0 & 63);
            tstore_pair(Tkf, TS, posb, kc8, scale8(rk[0], ex2(lgf * (float)(127 - j0))), scale8(rk[1], ex2(lgf * (float)(126 - j0))), kc8);
            tstore_pair(Tkb, TS, posb, kc8, scale8(rk[0], ex2(lgb * (float)j0)), scale8(rk[1], ex2(lgb * (float)(j0 + 1))), kc8); }
        __syncthreads();
        if (u + (int)gridDim.x < 2112) R1_LOAD(u + (int)gridDim.x);
        const int dir = wave >> 2, dvb = wave & 3;
        const uchar* Tk = dir ? Tkb : Tkf;
        f32x16 acc0 = {}, acc1 = {};
#pragma unroll
        for (int kk = 0; kk < 8; ++kk) {
            const bf16x8 av = *(const bf16x8*)(Tv + (dvb * 32 + l32) * TS + (16 * kk + 8 * hi) * 2);
            const bf16x8 b0 = *(const bf16x8*)(Tk + l32 * TS + (16 * kk + 8 * hi) * 2), b1 = *(const bf16x8*)(Tk + (32 + l32) * TS + (16 * kk + 8 * hi) * 2);
            acc0 = MFMA32(av, b0, acc0); acc1 = MFMA32(av, b1, acc1);
        }
        bf16_t* dst = dir ? dstb : dstf;
#pragma unroll
        for (int r = 0; r < 16; ++r) { bf16_t* p = dst + (dvb * 32 + crow(r, hi)) * 64 + l32; p[0] = (bf16_t)(pk2(acc0[r], 0.f) & 0xffffu); p[32] = (bf16_t)(pk2(acc1[r], 0.f) & 0xffffu); }
        __syncthreads();
    }
#undef R1_ROWS
#undef R1_HEAD
#undef R1_LOAD
}
__device__ __forceinline__ void phase_scan(bf16_t* ST, const bf16_t* CT, const float* dfw, const float* dbw, bool nostore = false) {
    const int gt = blockIdx.x * 512 + otid(), NT = gridDim.x * 512;
    for (int task = gt; task < 2 * 4 * 8 * 2048; task += NT) {
        const int e4 = task & 2047, bh = (task >> 11) & 31, dir = task >> 16, h = bh & 7;
        const float gC = ex2(-expf((dir ? dbw : dfw)[h]) * LOG2E * 128.f);
        u32x2* st = (u32x2*)(ST + ((size_t)(dir * 32 + bh) * 64) * 8192) + e4;
        const u32x2* ct = (const u32x2*)(CT + ((size_t)(dir * 32 + bh) * 2) * 8192) + e4;
        const u32x2 c0 = ct[0], c1 = ct[2048];
        float s0, s1, s2, s3;
        if (dir == 0) { s0 = gC * bf_lo(c0.x) + bf_lo(c1.x); s1 = gC * bf_hi(c0.x) + bf_hi(c1.x); s2 = gC * bf_lo(c0.y) + bf_lo(c1.y); s3 = gC * bf_hi(c0.y) + bf_hi(c1.y); }
        else { s0 = gC * bf_lo(c1.x) + bf_lo(c0.x); s1 = gC * bf_hi(c1.x) + bf_hi(c0.x); s2 = gC * bf_lo(c1.y) + bf_lo(c0.y); s3 = gC * bf_hi(c1.y) + bf_hi(c0.y); }
#pragma unroll 16
        for (int step = 0; step < 64; ++step) {
            const int n = dir ? 63 - step : step;
            const u32x2 t = st[(size_t)n * 2048];
            u32x2 o; o.x = pk2(s0, s1); o.y = pk2(s2, s3);
            if (!nostore) st[(size_t)n * 2048] = o; else if (s0 == 123.456f) st[0] = o;
            s0 = gC * s0 + bf_lo(t.x); s1 = gC * s1 + bf_hi(t.x); s2 = gC * s2 + bf_lo(t.y); s3 = gC * s3 + bf_hi(t.y);
        }
    }
}
__device__ __forceinline__ void phase_r3(bf16_t* P1, const bf16_t* ST, const bf16_t* CT, const float* dfw, const float* dbw, const float* gn, uchar* lds, bool with_ctx, bool nostore = false) {
    const int tid = otid(), lane = tid & 63, wave = tid >> 6, l32 = lane & 31, hi = lane >> 5, grp = wave >> 2, ib = wave & 3, tg = tid & 255;
    uchar* Tv = lds + grp * (128 * TS);
    const int nunits = with_ctx ? 2112 : 2048, npairs = nunits / 2;
    for (int it = blockIdx.x; it < npairs; it += gridDim.x) {
        const int u = 2 * it + grp;
        int b, h, rows0; const bf16_t* stf; const bf16_t* stb;
        if (u < 2048) { b = u >> 9; h = (u >> 6) & 7; const int n = u & 63; rows0 = b * SEQ + n * 128;
            stf = ST + ((size_t)((0 * 4 + b) * 8 + h) * 64 + n) * 8192; stb = ST + ((size_t)((1 * 4 + b) * 8 + h) * 64 + n) * 8192; }
        else { const int uc = u - 2048; b = uc >> 4; h = (uc >> 1) & 7; const int nc = uc & 1; rows0 = TL + b * LCTX + nc * 128;
            stf = nc == 1 ? CT + ((size_t)((0 * 4 + b) * 8 + h) * 2 + 0) * 8192 : nullptr; stb = nc == 0 ? CT + ((size_t)((1 * 4 + b) * 8 + h) * 2 + 1) * 8192 : nullptr; }
        const float lgf = -expf(dfw[h]) * LOG2E, lgb = -expf(dbw[h]) * LOG2E;
        bf16_t* qp = P1 + (size_t)rows0 * P1W + h * 64; const bf16_t* kp = qp + 512; bf16_t* vp = P1 + (size_t)rows0 * P1W + 1024 + h * 128;
#pragma unroll
        for (int i = 0; i < 4; ++i) { const int task = tg + 256 * i, pa = task >> 4, c8 = task & 15;
            const u32x4 r0 = *(const u32x4*)(vp + (size_t)(2 * pa) * P1W + 8 * c8), r1 = *(const u32x4*)(vp + (size_t)(2 * pa + 1) * P1W + 8 * c8);
            tstore_pair(Tv, TS, (2 * pa & 64) + pos64(2 * pa & 63), c8, r0, r1, c8); }
        __syncthreads();
        int il_ = ib * 32 + l32; asm volatile("" : "+v"(il_)); const int il = il_;
        bf16x8 qf[4];
#pragma unroll
        for (int s = 0; s < 4; ++s) qf[s] = *(const bf16x8*)(qp + (size_t)il * P1W + 16 * s + 8 * hi);
        f32x16 sT[4];
#pragma unroll
        for (int jb = 0; jb < 4; ++jb) { sT[jb] = (f32x16){};
#pragma unroll
            for (int s = 0; s < 4; ++s) { const bf16x8 kf = *(const bf16x8*)(kp + (size_t)(jb * 32 + l32) * P1W + 16 * s + 8 * hi); sT[jb] = MFMA32(kf, qf[s], sT[jb]); }
            if (jb & 1) asm volatile("" ::: "memory"); }
        const float fdl = (float)(il - 4 * hi);
#pragma unroll
        for (int jb = 0; jb < 4; ++jb)
#pragma unroll
            for (int r = 0; r < 16; ++r) { const float fd = fdl - (float)(jb * 32 + (r & 3) + 8 * (r >> 2));
                const float e = ex2(fd * (fd > 0.f ? lgf : -lgb)); sT[jb][r] *= (fd == 0.f ? 2.f : e); }
        f32x16 oT[4] = {};
#pragma unroll
        for (int kk = 0; kk < 8; ++kk) {
            const int jb = kk >> 1, r0 = 8 * (kk & 1);
            const bf16x8 pf = pack8(sT[jb][r0], sT[jb][r0 + 1], sT[jb][r0 + 2], sT[jb][r0 + 3], sT[jb][r0 + 4], sT[jb][r0 + 5], sT[jb][r0 + 6], sT[jb][r0 + 7]);
#pragma unroll
            for (int dvb = 0; dvb < 4; ++dvb) { const bf16x8 av = *(const bf16x8*)(Tv + (dvb * 32 + l32) * TS + (16 * kk + 8 * hi) * 2); oT[dvb] = MFMA32(av, pf, oT[dvb]); }
            if (kk & 1) asm volatile("" ::: "memory");
        }
#pragma unroll
        for (int dir = 0; dir < 2; ++dir) {
            const bf16_t* sp = dir ? stb : stf;
#ifdef R3_NO_CROSS
            sp = nullptr;
#endif
            if (sp) {
                const float dec = dir ? ex2(lgb * (float)(128 - il)) : ex2(lgf * (float)(il + 1));
#pragma unroll
                for (int s = 0; s < 4; ++s) {
                    const bf16x8 qd = __builtin_bit_cast(bf16x8, scale8(__builtin_bit_cast(u32x4, qf[s]), dec));
#pragma unroll
                    for (int dvb = 0; dvb < 4; ++dvb) { const bf16x8 av = *(const bf16x8*)(sp + (dvb * 32 + l32) * 64 + 16 * s + 8 * hi); oT[dvb] = MFMA32(av, qd, oT[dvb]); }
                    if (s & 1) asm volatile("" ::: "memory");
                }
            }
        }
        float sm = 0.f;
#pragma unroll
        for (int dvb = 0; dvb < 4; ++dvb)
#pragma unroll
            for (int r = 0; r < 16; ++r) sm += oT[dvb][r];
        sm += __shfl_xor(sm, 32); const float mu = sm * (1.f / 128.f);
        float sq = 0.f;
#pragma unroll
        for (int dvb = 0; dvb < 4; ++dvb)
#pragma unroll
            for (int r = 0; r < 16; ++r) { const float d = oT[dvb][r] - mu; sq += d * d; }
        sq += __shfl_xor(sq, 32); const float rstd = 1.f / sqrtf(sq * (1.f / 128.f) + EPSN);
        const float* gp = gn + h * 128;
#pragma unroll
        for (int dvb = 0; dvb < 4; ++dvb)
#pragma unroll
            for (int rq = 0; rq < 4; ++rq) { const int dv = 32 * dvb + 8 * rq + 4 * hi; const f32x4 g = *(const f32x4*)(gp + dv) * (1.f / LOG2E);
                u32x2 w; w.x = pk2((oT[dvb][4 * rq] - mu) * rstd * g.x, (oT[dvb][4 * rq + 1] - mu) * rstd * g.y); w.y = pk2((oT[dvb][4 * rq + 2] - mu) * rstd * g.z, (oT[dvb][4 * rq + 3] - mu) * rstd * g.w);
                if (!nostore || w.x == 0x12345678u) *(u32x2*)(vp + (size_t)il * P1W + dv) = w; if (rq == 3) asm volatile("" ::: "memory"); }
        __syncthreads();
    }
}

constexpr int KROW = 208, VROW = 144, KT_BYTES = 64 * KROW, VT_BYTES = 64 * VROW;
__device__ __forceinline__ void attn_unit(const bf16_t* Qm, const bf16_t* KVm, const bf16_t* P1, bf16_t* OP, int q0, int h, int klat, int nlat, int kctx, int nt, uchar* lds) {
    const int tid = otid(), lane = tid & 63, wave = tid >> 6, l32 = lane & 31, hi = lane >> 5;
    uchar* Kt = lds; uchar* Vt = lds + 2 * KT_BYTES;
    const bf16_t* qrow = Qm + (size_t)(q0 + wave * 32 + l32) * QMW + h * 96;
    bf16_t* orow = OP + (size_t)(q0 + wave * 32 + l32) * P1W + 2048 + h * 64;
    bf16x8 qf[6];
#pragma unroll
    for (int s = 0; s < 6; ++s) qf[s] = *(const bf16x8*)(qrow + 16 * s + 8 * hi);
    const int kr0 = tid / 12, kc0 = tid % 12, kr1 = (512 + tid) / 12, kc1 = (512 + tid) % 12;
    const int tv = tid - 256, va = tv >> 3, vc8 = tv & 7;
    u32x4 xk0, xa = (u32x4){0u, 0u, 0u, 0u}, xb = xa;
#define TILE_ROW(j) ((j) < nlat ? klat + 64 * (j) : kctx + 64 * ((j) - nlat))
#define LOADK(j) do { const int kb_ = TILE_ROW(j); \
        xk0 = kc0 < 8 ? *(const u32x4*)(KVm + (size_t)(kb_ + kr0) * KVW + h * 64 + 8 * kc0) : *(const u32x4*)(P1 + (size_t)(kb_ + kr0) * P1W + 2688 + 8 * (kc0 - 8)); \
        if (tid < 256) { xa = kc1 < 8 ? *(const u32x4*)(KVm + (size_t)(kb_ + kr1) * KVW + h * 64 + 8 * kc1) : *(const u32x4*)(P1 + (size_t)(kb_ + kr1) * P1W + 2688 + 8 * (kc1 - 8)); } } while (0)
#define LOADV(j) do { if (tid >= 256) { const int kb_ = TILE_ROW(j); \
        xa = *(const u32x4*)(KVm + (size_t)(kb_ + 2 * va) * KVW + 512 + h * 64 + 8 * vc8); xb = *(const u32x4*)(KVm + (size_t)(kb_ + 2 * va + 1) * KVW + 512 + h * 64 + 8 * vc8); } } while (0)
#define STOREK(buf) do { *(u32x4*)(Kt + (buf) * KT_BYTES + kr0 * KROW + kc0 * 16) = xk0; if (tid < 256) { *(u32x4*)(Kt + (buf) * KT_BYTES + kr1 * KROW + kc1 * 16) = xa; } } while (0)
#define STOREV(buf) do { if (tid >= 256) { tstore_pair(Vt + (buf) * VT_BYTES, VROW, pos64(2 * va), vc8, xa, xb); } } while (0)
    LOADK(0); LOADV(0); STOREK(0); STOREV(0); LOADK(1); STOREK(1);
    __syncthreads();
    f32x16 negm = {}, s0 = {}, s1 = {};
    { const uchar* kb = Kt + l32 * KROW + hi * 16;
#pragma unroll
      for (int s = 0; s < 6; ++s) { const bf16x8 a0 = *(const bf16x8*)(kb + s * 32), a1 = *(const bf16x8*)(kb + 32 * KROW + s * 32); s0 = MFMA32(a0, qf[s], s0); s1 = MFMA32(a1, qf[s], s1); } }
    __syncthreads();
    float mref = 0.f, lsum = 0.f; f32x16 o0 = {}, o1 = {};
    for (int t = 0; t < nt; ++t) {
        const int buf = t & 1;
        if (t + 2 < nt) LOADK(t + 2);
        if (t + 1 < nt) LOADV(t + 1);
        float ra = fmaxf(fmaxf(s0[0], s0[1]), s1[0]), rb = fmaxf(fmaxf(s0[2], s0[3]), s1[1]); ra = fmaxf(fmaxf(ra, s1[2]), s1[3]);
#pragma unroll
        for (int r = 4; r < 16; r += 4) { ra = fmaxf(fmaxf(ra, s0[r]), s0[r + 1]); rb = fmaxf(fmaxf(rb, s0[r + 2]), s0[r + 3]); ra = fmaxf(fmaxf(ra, s1[r]), s1[r + 1]); rb = fmaxf(fmaxf(rb, s1[r + 2]), s1[r + 3]); }
        float rm = fmaxf(ra, rb); rm = fmaxf(rm, __shfl_xor(rm, 32));
        if (t == 0 || __any(rm > 8.f)) {
            const float dl = t == 0 ? rm : fmaxf(rm, 0.f); mref += dl; const float f = ex2(fminf(-dl, 64.f)); lsum *= f; o0 *= f; o1 *= f; s0 -= dl; s1 -= dl;
#pragma unroll
            for (int r = 0; r < 16; ++r) negm[r] = -mref;
        }
        f32x16 n0 = negm, n1 = negm;
        { const uchar* kb = Kt + (buf ^ 1) * KT_BYTES + l32 * KROW + hi * 16;
#pragma unroll
          for (int s = 0; s < 6; ++s) { const bf16x8 a0 = *(const bf16x8*)(kb + s * 32), a1 = *(const bf16x8*)(kb + 32 * KROW + s * 32); n0 = MFMA32(a0, qf[s], n0); n1 = MFMA32(a1, qf[s], n1); } }
        float ps = 0.f;
#pragma unroll
        for (int r = 0; r < 16; ++r) { s0[r] = ex2(s0[r]); s1[r] = ex2(s1[r]); ps += s0[r] + s1[r]; }
        lsum += ps;
        const uchar* vb = Vt + buf * VT_BYTES + l32 * VROW + hi * 16;
#pragma unroll
        for (int kk = 0; kk < 4; ++kk) {
            const int r0 = 8 * (kk & 1);
            const bf16x8 pf = (kk >> 1) ? pack8(s1[r0], s1[r0 + 1], s1[r0 + 2], s1[r0 + 3], s1[r0 + 4], s1[r0 + 5], s1[r0 + 6], s1[r0 + 7])
                                        : pack8(s0[r0], s0[r0 + 1], s0[r0 + 2], s0[r0 + 3], s0[r0 + 4], s0[r0 + 5], s0[r0 + 6], s0[r0 + 7]);
            const bf16x8 a0 = *(const bf16x8*)(vb + kk * 32), a1 = *(const bf16x8*)(vb + 32 * VROW + kk * 32);
            o0 = MFMA32(a0, pf, o0); o1 = MFMA32(a1, pf, o1);
        }
        if (t + 2 < nt) STOREK(buf);
        if (t + 1 < nt) STOREV(buf ^ 1);
        __syncthreads();
        s0 = n0; s1 = n1;
    }
#undef TILE_ROW
#undef LOADK
#undef LOADV
#undef STOREK
#undef STOREV
    lsum += __shfl_xor(lsum, 32); const float inv = 1.f / lsum;
#pragma unroll
    for (int rq = 0; rq < 4; ++rq) {
        u32x2 w; w.x = pk2(o0[4 * rq] * inv, o0[4 * rq + 1] * inv); w.y = pk2(o0[4 * rq + 2] * inv, o0[4 * rq + 3] * inv);
        *(u32x2*)(orow + 8 * rq + 4 * hi) = w;
        w.x = pk2(o1[4 * rq] * inv, o1[4 * rq + 1] * inv); w.y = pk2(o1[4 * rq + 2] * inv, o1[4 * rq + 3] * inv);
        *(u32x2*)(orow + 32 + 8 * rq + 4 * hi) = w;
    }
}

__device__ __forceinline__ void attn_unit2(const bf16_t* Qm, const bf16_t* KVm, const bf16_t* P1, bf16_t* OP, int q0, int h, int klat, int nlat, int kctx, int nt, uchar* lds, bool nostore = false) {
    const int tid = otid(), lane = tid & 63, wave = tid >> 6, l32 = lane & 31, hi = lane >> 5;
    uchar* Kt = lds; uchar* Vt = lds + 2 * KT_BYTES;
    const bf16_t* qrowA = Qm + (size_t)(q0 + wave * 64 + l32) * QMW + h * 96; const bf16_t* qrowB = qrowA + (size_t)32 * QMW;
    bf16_t* orowA = OP + (size_t)(q0 + wave * 64 + l32) * P1W + 2048 + h * 64; bf16_t* orowB = orowA + (size_t)32 * P1W;
    bf16x8 qa[6], qb[6];
#pragma unroll
    for (int s = 0; s < 6; ++s) { qa[s] = *(const bf16x8*)(qrowA + 16 * s + 8 * hi); qb[s] = *(const bf16x8*)(qrowB + 16 * s + 8 * hi); }
    const int kr0 = tid / 12, kc0 = tid % 12, kr1 = (512 + tid) / 12, kc1 = (512 + tid) % 12;
    const int tv = tid - 256, va = tv >> 3, vc8 = tv & 7;
    u32x4 xk0, xa = (u32x4){0u, 0u, 0u, 0u}, xb = xa;
#define TILE_ROW(j) ((j) < nlat ? klat + 64 * (j) : kctx + 64 * ((j) - nlat))
#define LOADKV(j) do { const int kb_ = TILE_ROW(j); \
        xk0 = kc0 < 8 ? *(const u32x4*)(KVm + (size_t)(kb_ + kr0) * KVW + h * 64 + 8 * kc0) : *(const u32x4*)(P1 + (size_t)(kb_ + kr0) * P1W + 2688 + 8 * (kc0 - 8)); \
        if (tid < 256) { xa = kc1 < 8 ? *(const u32x4*)(KVm + (size_t)(kb_ + kr1) * KVW + h * 64 + 8 * kc1) : *(const u32x4*)(P1 + (size_t)(kb_ + kr1) * P1W + 2688 + 8 * (kc1 - 8)); } \
        else { xa = *(const u32x4*)(KVm + (size_t)(kb_ + 2 * va) * KVW + 512 + h * 64 + 8 * vc8); xb = *(const u32x4*)(KVm + (size_t)(kb_ + 2 * va + 1) * KVW + 512 + h * 64 + 8 * vc8); } } while (0)
#define STOREKV(buf) do { *(u32x4*)(Kt + (buf) * KT_BYTES + kr0 * KROW + kc0 * 16) = xk0; \
        if (tid < 256) { *(u32x4*)(Kt + (buf) * KT_BYTES + kr1 * KROW + kc1 * 16) = xa; } \
        else { tstore_pair(Vt + (buf) * VT_BYTES, VROW, pos64(2 * va), vc8, xa, xb); } } while (0)
    LOADKV(0); STOREKV(0);
    __syncthreads();
    float mA = -1e30f, mB = -1e30f, lA = 0.f, lB = 0.f; f32x16 oA0 = {}, oA1 = {}, oB0 = {}, oB1 = {};
    for (int t = 0; t < nt; ++t) {
        const int buf = t & 1;
        if (t + 1 < nt) LOADKV(t + 1);
        f32x16 sA0 = {}, sA1 = {}, sB0 = {}, sB1 = {};
        { const uchar* kb = Kt + buf * KT_BYTES + l32 * KROW + hi * 16;
          __builtin_amdgcn_s_setprio(1);
#pragma unroll
          for (int s = 0; s < 6; ++s) { const bf16x8 a0 = *(const bf16x8*)(kb + s * 32), a1 = *(const bf16x8*)(kb + 32 * KROW + s * 32);
              sA0 = MFMA32(a0, qa[s], sA0); sA1 = MFMA32(a1, qa[s], sA1); sB0 = MFMA32(a0, qb[s], sB0); sB1 = MFMA32(a1, qb[s], sB1); }
          __builtin_amdgcn_s_setprio(0); }
#define SOFTMAX_BLK(S0, S1, M, L, O0, O1) do { \
        float ra = fmaxf(fmaxf(S0[0], S0[1]), S1[0]), rb = fmaxf(fmaxf(S0[2], S0[3]), S1[1]); ra = fmaxf(fmaxf(ra, S1[2]), S1[3]); \
        _Pragma("unroll") for (int r = 4; r < 16; r += 4) { ra = fmaxf(fmaxf(ra, S0[r]), S0[r + 1]); rb = fmaxf(fmaxf(rb, S0[r + 2]), S0[r + 3]); ra = fmaxf(fmaxf(ra, S1[r]), S1[r + 1]); rb = fmaxf(fmaxf(rb, S1[r + 2]), S1[r + 3]); } \
        float rm = fmaxf(ra, rb); rm = fmaxf(rm, __shfl_xor(rm, 32)); \
        if (__any(rm > M + 8.f)) { const float mn = fmaxf(M, rm), f = ex2(M - mn); M = mn; L *= f; O0 *= f; O1 *= f; } \
        float ps = 0.f; \
        _Pragma("unroll") for (int r = 0; r < 16; ++r) { S0[r] = ex2(S0[r] - M); S1[r] = ex2(S1[r] - M); ps += S0[r] + S1[r]; } \
        L += ps; } while (0)
        SOFTMAX_BLK(sA0, sA1, mA, lA, oA0, oA1);
        SOFTMAX_BLK(sB0, sB1, mB, lB, oB0, oB1);
        const uchar* vb = Vt + buf * VT_BYTES + l32 * VROW + hi * 16;
#pragma unroll
        for (int kk = 0; kk < 4; ++kk) {
            const int r0 = 8 * (kk & 1);
            const bf16x8 pa = (kk >> 1) ? pack8(sA1[r0], sA1[r0 + 1], sA1[r0 + 2], sA1[r0 + 3], sA1[r0 + 4], sA1[r0 + 5], sA1[r0 + 6], sA1[r0 + 7])
                                        : pack8(sA0[r0], sA0[r0 + 1], sA0[r0 + 2], sA0[r0 + 3], sA0[r0 + 4], sA0[r0 + 5], sA0[r0 + 6], sA0[r0 + 7]);
            const bf16x8 pb = (kk >> 1) ? pack8(sB1[r0], sB1[r0 + 1], sB1[r0 + 2], sB1[r0 + 3], sB1[r0 + 4], sB1[r0 + 5], sB1[r0 + 6], sB1[r0 + 7])
                                        : pack8(sB0[r0], sB0[r0 + 1], sB0[r0 + 2], sB0[r0 + 3], sB0[r0 + 4], sB0[r0 + 5], sB0[r0 + 6], sB0[r0 + 7]);
            const bf16x8 a0 = *(const bf16x8*)(vb + kk * 32), a1 = *(const bf16x8*)(vb + 32 * VROW + kk * 32);
            oA0 = MFMA32(a0, pa, oA0); oA1 = MFMA32(a1, pa, oA1); oB0 = MFMA32(a0, pb, oB0); oB1 = MFMA32(a1, pb, oB1);
        }
        if (t + 1 < nt) STOREKV(buf ^ 1);
        __syncthreads();
    }
#undef SOFTMAX_BLK
#undef TILE_ROW
#undef LOADKV
#undef STOREKV
    lA += __shfl_xor(lA, 32); lB += __shfl_xor(lB, 32); const float iA = 1.f / lA, iB = 1.f / lB;
    if (nostore && iA != 123.456f) return;
#pragma unroll
    for (int rq = 0; rq < 4; ++rq) {
        u32x2 w; w.x = pk2(oA0[4 * rq] * iA, oA0[4 * rq + 1] * iA); w.y = pk2(oA0[4 * rq + 2] * iA, oA0[4 * rq + 3] * iA); *(u32x2*)(orowA + 8 * rq + 4 * hi) = w;
        w.x = pk2(oA1[4 * rq] * iA, oA1[4 * rq + 1] * iA); w.y = pk2(oA1[4 * rq + 2] * iA, oA1[4 * rq + 3] * iA); *(u32x2*)(orowA + 32 + 8 * rq + 4 * hi) = w;
        w.x = pk2(oB0[4 * rq] * iB, oB0[4 * rq + 1] * iB); w.y = pk2(oB0[4 * rq + 2] * iB, oB0[4 * rq + 3] * iB); *(u32x2*)(orowB + 8 * rq + 4 * hi) = w;
        w.x = pk2(oB1[4 * rq] * iB, oB1[4 * rq + 1] * iB); w.y = pk2(oB1[4 * rq + 2] * iB, oB1[4 * rq + 3] * iB); *(u32x2*)(orowB + 32 + 8 * rq + 4 * hi) = w;
    }
}
__device__ __forceinline__ void phase_attn(const bf16_t* Qm, const bf16_t* KVm, bf16_t* P1, uchar* lds, bool with_ctx, bool nostore = false) {
    const int c = blockIdx.x, G = gridDim.x;
#ifdef ATT_R64
    for (int uidx = c; uidx < 512; uidx += G) {
        int bh, qb;
        if (G == 256) { bh = 16 * (uidx >> 8) + (c & 7) + 8 * (c >> 7); qb = (c >> 3) & 15; } else { bh = uidx >> 4; qb = uidx & 15; }
        const int b = bh >> 3, h = bh & 7;
        attn_unit2(Qm, KVm, P1, P1, b * SEQ + qb * 512, h, b * SEQ, 128, TL + b * LCTX, 132, lds, nostore);
    }
#else
    for (int uidx = c; uidx < 1024; uidx += G) {
        int bh, qb;
        if (G == 256) { bh = 8 * (uidx >> 8) + (c & 7); qb = c >> 3; } else { bh = uidx >> 5; qb = uidx & 31; }
        const int b = bh >> 3, h = bh & 7;
        attn_unit(Qm, KVm, P1, P1, b * SEQ + qb * 256, h, b * SEQ, 128, TL + b * LCTX, 132, lds);
    }
#endif
    if (with_ctx && !nostore) for (int uidx = (G >= 64 ? c - 32 : c); uidx >= 0 && uidx < 32; uidx += G) { const int b = uidx >> 3, h = uidx & 7; attn_unit(Qm, KVm, P1, P1, TL + b * LCTX, h, 0, 0, TL + b * LCTX, 4, lds); }
}

#define LAS __attribute__((address_space(3)))
#define XB_TMO      128
#define XB_XCNT(j)  (256  + 64 * (j))
#define XB_XSUB(j)  (1280 + 64 * (j))
#define XB_XGEN(j)  (2304 + 64 * (j))
#define XB_TOP      3328
#define XB_TOPGEN   3392
#define XCD_BAR_WORDS 3456
#define XB_SPIN_CAP (1u << 18)

__device__ __forceinline__ unsigned xb_ld(unsigned* p)              { return __hip_atomic_load(p, __ATOMIC_RELAXED, __HIP_MEMORY_SCOPE_AGENT); }
__device__ __forceinline__ unsigned xb_add(unsigned* p, unsigned v) { return __hip_atomic_fetch_add(p, v, __ATOMIC_RELAXED, __HIP_MEMORY_SCOPE_AGENT); }
__device__ __forceinline__ unsigned xb_xcc_id() { return (unsigned)__builtin_amdgcn_s_getreg((3 << 11) | 20) & 0xFu; }
#define XB_SPIN(cond, bar) do { unsigned _sp = 0; while (cond) { __builtin_amdgcn_s_sleep(1); \
    if ((++_sp & 255u) == 0u) { if (xb_ld(&(bar)[XB_TMO])) break; if (_sp > XB_SPIN_CAP) { atomicAdd(&(bar)[XB_TMO], 1u); break; } } } } while (0)

struct XcdBarrier {
    unsigned* bar; unsigned x;
    volatile LAS unsigned* st;
};

__device__ __forceinline__ XcdBarrier xcd_barrier_post(unsigned* bar, volatile LAS unsigned* st) {
    XcdBarrier b; b.bar = bar; b.x = xb_xcc_id(); b.st = st;
    if (threadIdx.x == 0) (void)xb_add(&bar[XB_XCNT(b.x)], 1u);
    return b;
}
__device__ __forceinline__ void xcd_barrier_complete(unsigned* bar, unsigned x, unsigned& nloc, unsigned& nx) {
    const unsigned G = gridDim.x * gridDim.y * gridDim.z;
    unsigned sum, cnt, mine, sp = 0u;
    for (;;) {
        sum = 0u; cnt = 0u; mine = 0u;
#pragma unroll
        for (unsigned j = 0; j < 16; ++j) { const unsigned c = xb_ld(&bar[XB_XCNT(j)]); sum += c; cnt += (c > 0u) ? 1u : 0u; mine = (j == x) ? c : mine; }
        if (sum == G) break;
        __builtin_amdgcn_s_sleep(1);
        if ((++sp & 255u) == 0u) { if (xb_ld(&bar[XB_TMO])) break; if (sp > XB_SPIN_CAP) { atomicAdd(&bar[XB_TMO], 1u); break; } }
    }
    nloc = mine > 0u ? mine : 1u; nx = cnt > 0u ? cnt : 1u;
}

__device__ __forceinline__ void xcd_barrier(const XcdBarrier& b) {
    asm volatile("s_waitcnt vmcnt(0)" ::: "memory");
    __syncthreads();
    if (threadIdx.x == 0) {
        unsigned* bar = b.bar;
        __builtin_amdgcn_s_waitcnt(0);
        unsigned nloc = b.st[0], nx = b.st[1];
        if (nloc == 0u) { xcd_barrier_complete(bar, b.x, nloc, nx); b.st[0] = nloc; b.st[1] = nx; }
        const unsigned old = xb_add(&bar[XB_XSUB(b.x)], 1u);
        const unsigned gen = old / nloc;
        if (old + 1u == (gen + 1u) * nloc) {
            __builtin_amdgcn_fence(__ATOMIC_RELEASE, "agent");
            asm volatile("s_waitcnt vmcnt(0)" ::: "memory");
            const unsigned og = xb_add(&bar[XB_TOP], 1u);
            const unsigned tg = og / nx;
            if (og + 1u == (tg + 1u) * nx) xb_add(&bar[XB_TOPGEN], 1u);
            else XB_SPIN(xb_ld(&bar[XB_TOPGEN]) == tg, bar);
            __builtin_amdgcn_fence(__ATOMIC_ACQUIRE, "agent");
            xb_add(&bar[XB_XGEN(b.x)], 1u);
            asm volatile("s_waitcnt vmcnt(0)" ::: "memory");
        } else {
            XB_SPIN(xb_ld(&bar[XB_XGEN(b.x)]) == gen, bar);
            __builtin_amdgcn_fence(__ATOMIC_ACQUIRE, "agent");
            asm volatile("s_waitcnt vmcnt(0)" ::: "memory");
        }
    }
    __syncthreads();
}

constexpr int NPHASE = 30;
template <class Epi> __device__ __forceinline__ void run_gemm(uchar* lds, const bf16_t* A, int lda, const bf16_t* Bt, int N, int K, const Epi& E, int M = MR) {
    pg8::Gemm g{A, Bt, M, N, K, lda}; pg8::StaticOrder S; S.init(M, N, (int)gridDim.x, (int)blockIdx.x);
    pg8::gemm_phase<Epi, pg8::StaticOrder, true, true>((PG8_LAS unsigned char*)lds, g, S, E);
}
__global__ void __launch_bounds__(512, 2) mk_fwd(KArgs a) {
    extern __shared__ __attribute__((aligned(16))) unsigned char lds[];
    cg::grid_group grid = cg::this_grid();
    unsigned char* ws = a.ws;
    float* XC = (float*)(ws + WS_XC); const float* MOD = (const float*)(ws + WS_MOD); const float* RT = (const float*)(ws + WS_ROPE);
    bf16_t* WB = (bf16_t*)(ws + WS_W); bf16_t* XN = (bf16_t*)(ws + WS_XN); bf16_t* PA = (bf16_t*)(ws + WS_A);
    bf16_t* ST = (bf16_t*)(ws + WS_ST); bf16_t* CT = (bf16_t*)(ws + WS_CT); bf16_t* QM = (bf16_t*)(ws + WS_QM); bf16_t* KVM = (bf16_t*)(ws + WS_KVM);
    float* XL = a.out;
    const int lo = a.ph_lo, hi = a.ph_hi;
    volatile LAS unsigned* ldsctl = (volatile LAS unsigned*)((LAS unsigned char*)lds + 139264);
    if (threadIdx.x < 2) ldsctl[threadIdx.x] = 0u;
    __syncthreads();
    XcdBarrier bar; bar.bar = (unsigned*)(ws + WS_CTL); bar.x = 0; bar.st = ldsctl;
    if (hi - lo > 1) bar = xcd_barrier_post((unsigned*)(ws + WS_CTL), ldsctl);
#ifdef PH_ONLY
#define PH_ON(rel) ((rel) == PH_ONLY)
#else
#define PH_ON(rel) true
#endif
#ifndef SKIP_SCAN
#define SKIP_SCAN 0
#endif
#ifndef SKIP_R3
#define SKIP_R3 0
#endif
#ifndef MIX_VARIANT
#define MIX_VARIANT 0
#endif
#ifndef PH_LIMIT
#define PH_LIMIT 100
#endif
#define PH_BEGIN(k) if (lo <= (k) && (k) < hi && ((k) < PH_LIMIT || (k) == 29) && PH_ON((k) == 0 ? 0 : ((k) == 29 ? 15 : (k) - pb + 1))) {
#ifndef PH_SUB
#define PH_SUB 255
#endif
#define SUB(n) ((PH_SUB >> (n)) & 1)
#ifdef PROBE_BAR2
#define PH_END(k) if ((k) + 1 < hi) { if ((k) == 0) grid.sync(); else { xcd_barrier(bar); xcd_barrier(bar); } } }
#else
#define PH_END(k) if ((k) + 1 < hi) { if ((k) == 0) grid.sync(); else xcd_barrier(bar); } }
#endif
    { const int pb = 1; PH_BEGIN(0) phase_mods(a, lds); __syncthreads(); phase_conv(a, lds, 0); PH_END(0) }
    for (int l = 0; l < 2; ++l) {
        const int pb = 1 + 14 * l;
        const float* mod = MOD + (size_t)l * 5 * NMOD;
        const float* xl_in = l == 0 ? a.in[0] : XL; const float* xc_in = l == 0 ? a.in[2] : XC;
        const float* dfw = a.in[13] + l * 8; const float* dbw = a.in[14] + l * 8;
        const int ML = l == 1 ? TL : MR;
        const bool early_conv = gridDim.x == 256;
        PH_BEGIN(pb + 0) if (l > 0) phase_conv(a, lds, l, early_conv ? 2 : 0, 0); phase_norm(xl_in, xc_in, mod, 0, XN); PH_END(pb + 0)
        PH_BEGIN(pb + 1) run_gemm(lds, XN, DM, WB + WE_UP1, 5632, DM, EpiUp{PA});
#ifdef PROBE_UP2X
            run_gemm(lds, XN, DM, WB + WE_UP1, 5632, DM, EpiUp{PA});
#endif
        PH_END(pb + 1)
        PH_BEGIN(pb + 2) run_gemm(lds, PA, DFF, WB + WE_DN1, DM, DFF, EpiRes{xl_in, xc_in, XL, XC, mod + 2048, 0.5f}, TL);
            ctx_gemm(PA + (size_t)TL * DFF, DFF, WB + WE_DN1, DFF, FinRes{xc_in, XC, mod + 4 * NMOD + 2048, 0.5f}, lds); PH_END(pb + 2)
        PH_BEGIN(pb + 3) phase_norm(XL, XC, mod, 3072, XN); PH_END(pb + 3)
        PH_BEGIN(pb + 4) run_gemm(lds, XN, DM, WB + WE_IN, P1W, DM, EpiRope<false>{PA, RT, RT + 2048, RT + 4096, RT + 5120}); PH_END(pb + 4)
        PH_BEGIN(pb + 5) phase_r1(PA, ST, CT, dfw, dbw, lds);
#ifdef PROBE_RET
            phase_r1(PA, ST, CT, dfw, dbw, lds);
#endif
 phase_mla_prep(PA, a.in[16] + l * 384, a.in[17] + l * 256); PH_END(pb + 5)
        PH_BEGIN(pb + 6)
#ifdef PROBE_RET
            phase_scan(ST, CT, dfw, dbw, a.ph_hi > 0);
#endif
            if (SUB(0) && !SKIP_SCAN) phase_scan(ST, CT, dfw, dbw, a.ph_hi < 0);
            if (SUB(1)) run_gemm(lds, PA + 2048, P1W, WB + WE_UQ, QMW, 384, EpiRope<true>{QM, RT, RT + 2048, RT + 4096, RT + 5120}, ML);
            run_gemm(lds, PA + 2432, P1W, WB + WE_UKV, KVW, 256, EpiBf<0>{KVM, KVW, nullptr, 0}, TL);
            ctx_gemm(PA + (size_t)TL * P1W + 2432, P1W, WB + WE_UKV, 256, FinBf<0>{KVM + (size_t)TL * KVW, KVW, nullptr, 0}, lds); PH_END(pb + 6)
        PH_BEGIN(pb + 7)
#ifdef PROBE_ATT
            phase_attn(QM, KVM, PA, lds, l == 0, a.ph_hi > 0); __syncthreads();
#endif
            if (SUB(0)) phase_attn(QM, KVM, PA, lds, l == 0, a.ph_hi < 0); __syncthreads();
#ifdef PROBE_RET
            phase_r3(PA, ST, CT, dfw, dbw, a.in[15] + l * 1024, lds, l == 0, a.ph_hi > 0);
#endif
            if (SUB(1) && !SKIP_R3) phase_r3(PA, ST, CT, dfw, dbw, a.in[15] + l * 1024, lds, l == 0, a.ph_hi < 0); PH_END(pb + 7)
        bf16_t* PAc = PA + (size_t)TL * P1W; const bf16_t* XNc = XN + (size_t)TL * DM; bf16_t* KVMc = KVM + (size_t)TL * KVW;
        PH_BEGIN(pb + 8) run_gemm(lds, XN, DM, WB + WE_G, DM, DM, EpiBf<1>{PA + 1024, P1W, nullptr, 0}, TL);
            if (l == 0) ctx_gemm(XNc, DM, WB + WE_G, DM, FinBf<1>{PAc + 1024, P1W, nullptr, 0}, lds); PH_END(pb + 8)
        PH_BEGIN(pb + 9)
            run_gemm(lds, PA + 1024, P1W, WB + WE_RO, DM, DM, EpiBf<0>{PA, P1W, nullptr, 0}, TL);
            run_gemm(lds, XN, DM, WB + WE_GR, DM, DM, EpiBf<2>{PA, P1W, nullptr, 0}, TL);
            run_gemm(lds, PA + 2048, P1W, WB + WE_MO, DM, 512, EpiBf<0>{KVM, KVW, nullptr, 0}, TL);
            run_gemm(lds, XN, DM, WB + WE_GM, DM, DM, EpiBf<3>{PA, P1W, KVM, KVW}, TL);
            if (l == 0) {
                ctx_gemm(PAc + 1024, P1W, WB + WE_RO, DM, FinBf<0>{PAc, P1W, nullptr, 0}, lds);
                ctx_gemm(XNc, DM, WB + WE_GR, DM, FinBf<2>{PAc, P1W, nullptr, 0}, lds);
                ctx_gemm(PAc + 2048, P1W, WB + WE_MO, 512, FinBf<0>{KVMc, KVW, nullptr, 0}, lds);
                ctx_gemm(XNc, DM, WB + WE_GM, DM, FinBf<3>{PAc, P1W, KVMc, KVW}, lds);
            }
        PH_END(pb + 9)
        PH_BEGIN(pb + 10) run_gemm(lds, PA, P1W, WB + WE_WO, DM, DM, EpiRes{XL, XC, XL, XC, mod + 5120, 1.0f}, TL);
            if (l == 0) ctx_gemm(PA + (size_t)TL * P1W, P1W, WB + WE_WO, DM, FinRes{XC, XC, mod + 4 * NMOD + 5120, 1.0f}, lds); PH_END(pb + 10)
        PH_BEGIN(pb + 11) phase_norm(XL, XC, mod, 6144, XN, ML); PH_END(pb + 11)
        PH_BEGIN(pb + 12) run_gemm(lds, XN, DM, WB + WE_UP2, 5632, DM, EpiUp{PA}, ML);
            if (l == 0 && early_conv && blockIdx.x >= 88) phase_conv(a, lds, 1, 1, 88);
        PH_END(pb + 12)
        PH_BEGIN(pb + 13) run_gemm(lds, PA, DFF, WB + WE_DN2, DM, DFF, EpiRes{XL, XC, XL, XC, mod + 8192, 0.5f}, TL);
            if (l == 0) ctx_gemm(PA + (size_t)TL * DFF, DFF, WB + WE_DN2, DFF, FinRes{XC, XC, mod + 4 * NMOD + 8192, 0.5f}, lds); PH_END(pb + 13)
    }
    { const int pb = 1; PH_BEGIN(29) phase_final_norm(XL, a.in[23]); PH_END(29) }
#undef PH_BEGIN
#undef PH_END
}

#ifndef MK_N_LAUNCHES
#define MK_N_LAUNCHES 30
#endif
extern "C" void kernel_launch(void* const* d_in, const int* in_sizes, int n_in, void* d_out, int out_size, void* d_ws, size_t ws_size, hipStream_t stream) {
    static int grid = 0;
    if (grid == 0) {
        if (n_in != 24 || out_size != TL * DM || ws_size < WS_END) { fprintf(stderr, "kernel_launch: unexpected shapes (n_in %d out %d ws %zu)\n", n_in, out_size, ws_size); grid = -1; return; }
        int dev = 0, cus = 0, per_cu = 0;
        hipGetDevice(&dev); hipDeviceGetAttribute(&cus, hipDeviceAttributeMultiprocessorCount, dev);
        if (hipFuncSetAttribute((const void*)mk_fwd, hipFuncAttributeMaxDynamicSharedMemorySize, LDS_BYTES) != hipSuccess) { fprintf(stderr, "kernel_launch: hipFuncSetAttribute failed\n"); grid = -1; return; }
        if (hipOccupancyMaxActiveBlocksPerMultiprocessor(&per_cu, (const void*)mk_fwd, 512, LDS_BYTES) != hipSuccess || per_cu < 1) { fprintf(stderr, "kernel_launch: occupancy query says %d\n", per_cu); per_cu = 1; }
        (void)hipGetLastError();
        grid = cus * 1;
    }
    if (grid < 0) return;
    if (hipMemsetAsync((char*)d_ws + WS_CTL, 0, 16384, stream) != hipSuccess) { fprintf(stderr, "kernel_launch: hipMemsetAsync failed\n"); return; }
    KArgs a{};
    for (int i = 0; i < 24; ++i) a.in[i] = (const float*)d_in[i];
    a.out = (float*)d_out; a.ws = (unsigned char*)d_ws;
    if (MK_N_LAUNCHES == 1) {
        a.ph_lo = 0; a.ph_hi = NPHASE;
        void* args[] = {&a};
        hipError_t e = hipLaunchCooperativeKernel((const void*)mk_fwd, dim3(grid), dim3(512), args, LDS_BYTES, stream);
        if (e != hipSuccess) fprintf(stderr, "cooperative launch failed: %s (grid %d)\n", hipGetErrorString(e), grid);
    } else {
        for (int p = 0; p < NPHASE; ++p) { a.ph_lo = p; a.ph_hi = p + 1; hipLaunchKernelGGL(mk_fwd, dim3(grid), dim3(512), LDS_BYTES, stream, a); }
    }
}
```

```cpp
#define MK_N_LAUNCHES 1
#define ATT_R64 1
#define PG8_ALIGN_EPI true
#define PG8_SP2_K true
#include <hip/hip_runtime.h>
#include <hip/hip_cooperative_groups.h>
#include <cstdio>
#include <cstdint>
#include <cmath>
namespace cg = cooperative_groups;
namespace pg8 {
#define PG8_LAS __attribute__((address_space(3)))
typedef unsigned short bf16_t;
typedef short bf16x8 __attribute__((ext_vector_type(8)));
typedef float f32x4 __attribute__((ext_vector_type(4)));
typedef unsigned u32x4 __attribute__((ext_vector_type(4)));
constexpr int BM = 256, BK = 64, HALF = 128, HTB = HALF * BK * 2  , STAGE_BYTES = 8 * HTB, NXCD = 8, WGM = 4;

__host__ __device__ __forceinline__ int lds_byte(int r, int c) { const int st = (r >> 4) * 2 + (c >> 5), rr = r & 15, cc = c & 31, ob = rr * 64 + cc * 2; return st * 1024 + (ob ^ (((ob >> 9) & 1) << 5)); }
__host__ __device__ __forceinline__ void stage_rc(int b, int& R, int& C) { const int st = b / 1024, sb = b % 1024, swz = sb ^ (((sb >> 9) & 1) << 5); R = (st >> 1) * 16 + swz / 64; C = (st & 1) * 32 + (swz % 64) / 2; }
__host__ __device__ __forceinline__ int perm32(int rho) { const int n = rho >> 4, i = rho & 15; return 8 * (i >> 2) + 4 * n + (i & 3); }

struct Unit { int pm, pn; };
struct Gemm { const bf16_t* A; const bf16_t* Bt; int M, N, K, lda; };

struct StaticOrder {
    int nM, nN, nwg, G, c;
    __host__ __device__ void init(int M, int N, int G_, int c_) { nM = M / BM; nN = N / BM; nwg = nM * nN; G = G_; c = c_; }
    __host__ __device__ bool next(int i, Unit& u) const {
        const long L = (long)i * G + c; if (L >= nwg) return false;
        int wgid = (int)L; { const int q = nwg / NXCD, r = nwg % NXCD, xcd = wgid % NXCD, off = wgid / NXCD; wgid = (xcd < r ? xcd * (q + 1) : r * (q + 1) + (xcd - r) * q) + off; }
        const int nig = WGM * nN, gid = wgid / nig, fm = gid * WGM, gsz = (nM - fm) < WGM ? (nM - fm) : WGM;
        u.pm = fm + ((wgid % nig) % gsz); u.pn = (wgid % nig) / gsz; return true;
    }
    __device__ __forceinline__ void a_ready(const Unit&) const {}
    __device__ __forceinline__ void done(const Unit&) const {}
};

__device__ __forceinline__ unsigned cvt_pk_bf16(float lo, float hi) { unsigned r; asm volatile("v_cvt_pk_bf16_f32 %0, %1, %2" : "=v"(r) : "v"(lo), "v"(hi)); return r; }
typedef float f32x2 __attribute__((ext_vector_type(2)));
template <class Epi, class Sched, bool ALIGN_EPI = false, bool SP2 = false>
__device__ __forceinline__ void gemm_phase(PG8_LAS unsigned char* lds, const Gemm g, const Sched& S, const Epi& E) {
    int tid_ = threadIdx.x; asm volatile("" : "+v"(tid_)); const int tid = tid_, wid = __builtin_amdgcn_readfirstlane(tid >> 6), lane = tid & 63, wr = wid >> 2, wc = wid & 3, fr = lane & 15, fq = lane >> 4;
    const int K = g.K, nt = K / BK;
    unsigned voffA[2], voffB[2];
#pragma unroll
    for (int i = 0; i < 2; ++i) { int R, C; stage_rc(tid * 16 + i * 8192, R, C); const int Rb = Epi::PERM ? ((R & ~31) + perm32(R & 31)) : R;
        voffA[i] = (unsigned)(R * g.lda + C) * 2u; voffB[i] = (unsigned)(Rb * K + C) * 2u; }
    const size_t kstep = (size_t)(BK * 2);
    const size_t hstepA = (size_t)HALF * g.lda * 2, hstepB = (size_t)HALF * K * 2;
    const size_t tstepA = 2 * hstepA, tstepB = 2 * hstepB;
    const unsigned ldsw = (unsigned)wid * 1024u;
    const int aoff = lds_byte(wr * 64 + fr, fq * 8), boff = lds_byte(wc * 32 + fr, fq * 8);
#define PG8_SA(b, h) (((b) * 2 + (h)) * HTB)
#define PG8_SB(b, h) ((4 + (b) * 2 + (h)) * HTB)
#define PG8_STAGE(bufoff, gbase, voff) do { _Pragma("unroll") for (int _i = 0; _i < 2; ++_i) \
        __builtin_amdgcn_global_load_lds((const unsigned*)((const char*)(gbase) + (voff)[_i]), (PG8_LAS unsigned*)(lds + (bufoff) + ldsw + _i * 8192), 16, 0, 0); } while (0)
#define PG8_LDA(dst, b, h) do { _Pragma("unroll") for (int m = 0; m < 4; ++m) _Pragma("unroll") for (int k = 0; k < 2; ++k) dst[m][k] = *(const PG8_LAS bf16x8*)(lds + PG8_SA(b, h) + aoff + m * 2048 + k * 1024); } while (0)
#define PG8_LDB(dst, b, h) do { _Pragma("unroll") for (int n = 0; n < 2; ++n) _Pragma("unroll") for (int k = 0; k < 2; ++k) dst[n][k] = *(const PG8_LAS bf16x8*)(lds + PG8_SB(b, h) + boff + n * 2048 + k * 1024); } while (0)
#define PG8_MMA(ai, bj, At, Bt) do { __builtin_amdgcn_s_setprio(1); _Pragma("unroll") for (int m = 0; m < 4; ++m) _Pragma("unroll") for (int n = 0; n < 2; ++n) _Pragma("unroll") for (int k = 0; k < 2; ++k) \
        acc[ai][bj][m][n] = __builtin_amdgcn_mfma_f32_16x16x32_bf16(Bt[n][k], At[m][k], acc[ai][bj][m][n], 0, 0, 0); __builtin_amdgcn_s_setprio(0); } while (0)
#define PG8_WAIT_V(n) asm volatile("s_waitcnt vmcnt(" #n ")" ::: "memory")
#define PG8_WAIT_L(n) asm volatile("s_waitcnt lgkmcnt(" #n ")" ::: "memory")
#define PG8_BAR __builtin_amdgcn_s_barrier()
#define PG8_SCHED __builtin_amdgcn_sched_barrier(0)
    Unit cur, nxt; int ui = 0;
    if (!S.next(0, cur)) return;
    f32x4 acc[2][2][4][2];
#pragma unroll
    for (int a = 0; a < 2; ++a)
#pragma unroll
        for (int b = 0; b < 2; ++b)
#pragma unroll
            for (int m = 0; m < 4; ++m)
#pragma unroll
                for (int n = 0; n < 2; ++n) acc[a][b][m][n] = (f32x4){0.f, 0.f, 0.f, 0.f};
    bf16x8 At[4][2], B0[2][2], B1[2][2];
    const char* cA = (const char*)g.A + (size_t)cur.pm * tstepA; const char* cB = (const char*)g.Bt + (size_t)cur.pn * tstepB;
    S.a_ready(cur);
    if constexpr (SP2) {
        PG8_STAGE(PG8_SB(0, 0), cB, voffB); PG8_STAGE(PG8_SB(0, 1), cB + hstepB, voffB); PG8_STAGE(PG8_SA(0, 0), cA, voffA); PG8_STAGE(PG8_SA(0, 1), cA + hstepA, voffA);
        if (wr == 1) PG8_BAR;
        PG8_WAIT_V(2); PG8_BAR;
        PG8_STAGE(PG8_SB(1, 0), cB + kstep, voffB); PG8_STAGE(PG8_SA(1, 0), cA + kstep, voffA); PG8_STAGE(PG8_SB(1, 1), cB + hstepB + kstep, voffB);
        PG8_WAIT_V(6); PG8_BAR;
    } else {
        PG8_STAGE(PG8_SB(0, 0), cB, voffB); PG8_STAGE(PG8_SA(0, 0), cA, voffA); PG8_STAGE(PG8_SB(0, 1), cB + hstepB, voffB); PG8_STAGE(PG8_SA(0, 1), cA + hstepA, voffA);
        if (wr == 1) PG8_BAR;
        PG8_WAIT_V(4); PG8_BAR;
        PG8_STAGE(PG8_SB(1, 0), cB + kstep, voffB); PG8_STAGE(PG8_SA(1, 0), cA + kstep, voffA); PG8_STAGE(PG8_SB(1, 1), cB + hstepB + kstep, voffB);
        PG8_WAIT_V(6); PG8_BAR;
    }
    for (;;) {
        const bool has_next = S.next(ui + 1, nxt);
        const char* nA = has_next ? (const char*)g.A + (size_t)nxt.pm * tstepA : cA; const char* nB = has_next ? (const char*)g.Bt + (size_t)nxt.pn * tstepB : cB;
#pragma nounroll
        for (int t = 0; t < nt; t += 2) {
            const bool last = (t == nt - 2);
            const char* a1 = cA + (size_t)(t + 1) * kstep;
            const char* a2 = last ? nA : cA + (size_t)(t + 2) * kstep; const char* b2 = last ? nB : cB + (size_t)(t + 2) * kstep;
            const char* a3 = a2 + kstep; const char* b3 = b2 + kstep;
            if (last && has_next) S.a_ready(nxt);
            if constexpr (SP2) {
            PG8_LDB(B0, 0, 0); PG8_LDB(B1, 0, 1); PG8_SCHED; PG8_LDA(At, 0, 0); PG8_STAGE(PG8_SA(1, 1), a1 + hstepA, voffA);
            PG8_WAIT_V(8); PG8_WAIT_L(0); PG8_BAR; PG8_MMA(0, 0, At, B0); PG8_MMA(0, 1, At, B1); PG8_BAR; PG8_SCHED;
            PG8_LDA(At, 0, 1); PG8_STAGE(PG8_SB(0, 0), b2, voffB); PG8_STAGE(PG8_SB(0, 1), b2 + hstepB, voffB); PG8_STAGE(PG8_SA(0, 0), a2, voffA);
            PG8_WAIT_V(8); PG8_WAIT_L(0); PG8_BAR; PG8_MMA(1, 0, At, B0); PG8_MMA(1, 1, At, B1); PG8_BAR; PG8_SCHED;
            PG8_LDB(B0, 1, 0); PG8_LDB(B1, 1, 1); PG8_SCHED; PG8_LDA(At, 1, 0); PG8_STAGE(PG8_SA(0, 1), a2 + hstepA, voffA);
            PG8_WAIT_V(8); PG8_WAIT_L(0); PG8_BAR; PG8_MMA(0, 0, At, B0); PG8_MMA(0, 1, At, B1); PG8_BAR; PG8_SCHED;
            PG8_LDA(At, 1, 1); PG8_STAGE(PG8_SB(1, 0), b3, voffB); PG8_STAGE(PG8_SB(1, 1), b3 + hstepB, voffB); PG8_STAGE(PG8_SA(1, 0), a3, voffA);
            PG8_WAIT_V(8); PG8_WAIT_L(0); PG8_BAR; PG8_MMA(1, 0, At, B0); PG8_MMA(1, 1, At, B1); PG8_BAR; PG8_SCHED;
            } else {
            PG8_LDB(B0, 0, 0); PG8_SCHED; PG8_LDA(At, 0, 0); PG8_STAGE(PG8_SA(1, 1), a1 + hstepA, voffA);
            PG8_WAIT_L(8); PG8_BAR; PG8_WAIT_L(0); PG8_MMA(0, 0, At, B0); PG8_BAR; PG8_SCHED;
            PG8_LDB(B1, 0, 1); PG8_STAGE(PG8_SB(0, 0), b2, voffB);
            PG8_BAR; PG8_WAIT_L(0); PG8_MMA(0, 1, At, B1); PG8_BAR;
            PG8_LDA(At, 0, 1); PG8_STAGE(PG8_SA(0, 0), a2, voffA);
            PG8_BAR; PG8_WAIT_L(0); PG8_MMA(1, 0, At, B0); PG8_BAR; PG8_SCHED;
            PG8_STAGE(PG8_SB(0, 1), b2 + hstepB, voffB);
            PG8_WAIT_V(6); PG8_BAR; PG8_MMA(1, 1, At, B1); PG8_BAR;
            PG8_LDB(B0, 1, 0); PG8_SCHED; PG8_LDA(At, 1, 0); PG8_STAGE(PG8_SA(0, 1), a2 + hstepA, voffA);
            PG8_WAIT_L(8); PG8_BAR; PG8_WAIT_L(0); PG8_MMA(0, 0, At, B0); PG8_BAR; PG8_SCHED;
            PG8_LDB(B1, 1, 1); PG8_STAGE(PG8_SB(1, 0), b3, voffB);
            PG8_BAR; PG8_WAIT_L(0); PG8_MMA(0, 1, At, B1); PG8_BAR;
            PG8_LDA(At, 1, 1); PG8_STAGE(PG8_SA(1, 0), a3, voffA);
            PG8_BAR; PG8_WAIT_L(0); PG8_MMA(1, 0, At, B0); PG8_BAR; PG8_SCHED;
            PG8_STAGE(PG8_SB(1, 1), b3 + hstepB, voffB);
            PG8_WAIT_V(6); PG8_BAR; PG8_MMA(1, 1, At, B1); PG8_BAR;
            }
        }
        if constexpr (ALIGN_EPI) { if (wr == 0) PG8_BAR; }
        if constexpr (!Epi::AFTER_DRAIN) { E(acc, cur, wr, wc, fr, fq); S.done(cur); }
        if (!has_next) break;
#pragma unroll
        for (int a = 0; a < 2; ++a)
#pragma unroll
            for (int b = 0; b < 2; ++b)
#pragma unroll
                for (int m = 0; m < 4; ++m)
#pragma unroll
                    for (int n = 0; n < 2; ++n) acc[a][b][m][n] = (f32x4){0.f, 0.f, 0.f, 0.f};
        cur = nxt; cA = nA; cB = nB; ++ui;
        if constexpr (ALIGN_EPI) { if (wr == 1) PG8_BAR; }
    }
    PG8_WAIT_V(0);
    if constexpr (!ALIGN_EPI) { if (wr == 0) PG8_BAR; }
    PG8_BAR;
    if constexpr (Epi::AFTER_DRAIN) { E.fused(acc, cur, wr, wc, fr, fq, lds, wid, lane); S.done(cur); }
#undef PG8_SA
#undef PG8_SB
#undef PG8_STAGE
#undef PG8_LDA
#undef PG8_LDB
#undef PG8_MMA
#undef PG8_WAIT_V
#undef PG8_WAIT_L
#undef PG8_BAR
#undef PG8_SCHED
}
}

using pg8::bf16_t; using pg8::bf16x8; using pg8::f32x4; using pg8::u32x4;
typedef float f32x16 __attribute__((ext_vector_type(16)));
typedef unsigned u32x2 __attribute__((ext_vector_type(2)));
typedef unsigned char uchar;
constexpr int NB = 4, SEQ = 8192, DM = 1024, LCTX = 256, DFF = 2816;
constexpr int TL = NB * SEQ;
constexpr int TC = NB * LCTX;
constexpr int MR = TL + TC;
constexpr int NMOD = 9 * DM;
constexpr int INW = 5792;
constexpr int P1W = 2816;
constexpr int QMW = 768, KVW = 1024;
constexpr float EPSN = 1e-6f;
constexpr float LOG2E = 1.4426950408889634f;
constexpr float MLA_C2 = 0.10206207261596575f * 1.4426950408889634f;
constexpr int LDS_BYTES = 147456;

constexpr size_t WS_XC = 0;
constexpr size_t WS_MOD = 4194304;
constexpr size_t WS_ROPE = 4718592;
constexpr size_t WS_W = 5242880;
constexpr size_t WE_UP1 = 0, WE_DN1 = 5767168, WE_UP2 = 8650752, WE_DN2 = 14417920, WE_IN = 17301504, WE_G = 20185088, WE_GR = 21233664, WE_GM = 22282240,
                 WE_UQ = 23330816, WE_UKV = 23625728, WE_RO = 23887872, WE_MO = 24936448, WE_WO = 25722880, WE_END = 26771456;
constexpr size_t WS_XN = WS_W + WE_END * 2;
constexpr size_t WS_A = WS_XN + (size_t)MR * DM * 2;
constexpr size_t WS_ST = WS_A + (size_t)MR * P1W * 2;
constexpr size_t WS_CT = WS_ST + 67108864;
constexpr size_t WS_QM = WS_CT + 2097152;
constexpr size_t WS_KVM = WS_QM + (size_t)MR * QMW * 2;
constexpr size_t WS_CTL = WS_KVM + (size_t)MR * KVW * 2;
constexpr size_t WS_END = WS_CTL + 16384;
static_assert(WS_END <= 536870912 && WS_CTL % 256 == 0, "workspace map exceeds 512 MiB");

struct KArgs { const float* in[24]; float* out; unsigned char* ws; int ph_lo, ph_hi; };

__device__ __forceinline__ int otid() { int t = threadIdx.x; asm volatile("" : "+v"(t)); return t; }
typedef float f32x2_t __attribute__((ext_vector_type(2))); typedef __bf16 bf16x2_t __attribute__((ext_vector_type(2)));
__device__ __forceinline__ unsigned pk2(float lo, float hi) { f32x2_t v = {lo, hi}; bf16x2_t b = __builtin_convertvector(v, bf16x2_t); return __builtin_bit_cast(unsigned, b); }
__device__ __forceinline__ float bf_lo(unsigned w) { return __uint_as_float(w << 16); }
__device__ __forceinline__ float bf_hi(unsigned w) { return __uint_as_float(w & 0xffff0000u); }
__device__ __forceinline__ float ex2(float x) { return __builtin_amdgcn_exp2f(x); }
__device__ __forceinline__ float sigm(float a) { return __builtin_amdgcn_rcpf(1.f + __builtin_amdgcn_exp2f(-a * LOG2E)); }
__device__ __forceinline__ float silu(float a) { return a * sigm(a); }
__device__ __forceinline__ float sigm2(float a2) { return __builtin_amdgcn_rcpf(1.f + __builtin_amdgcn_exp2f(-a2)); }
__device__ __forceinline__ int crow(int r, int hi) { return (r & 3) + 8 * (r >> 2) + 4 * hi; }
__device__ __forceinline__ int pos64(int kv) { const int p = kv >> 5, w = kv & 31; return 16 * (2 * p + (w >> 4)) + 8 * ((w >> 2) & 1) + (w & 3) + 4 * ((w >> 3) & 1); }
__device__ __forceinline__ float max_xor32(float v) { const auto rr = __builtin_amdgcn_permlane32_swap(__float_as_uint(v), __float_as_uint(v), false, false); return fmaxf(__uint_as_float(rr[0]), __uint_as_float(rr[1])); }
__device__ __forceinline__ float wave_sum(float v) {
#pragma unroll
    for (int o = 1; o < 64; o <<= 1) v += __shfl_xor(v, o);
    return v;
}
__device__ __forceinline__ bf16x8 pack8(float a0, float a1, float a2, float a3, float a4, float a5, float a6, float a7) {
    u32x4 w; w.x = pk2(a0, a1); w.y = pk2(a2, a3); w.z = pk2(a4, a5); w.w = pk2(a6, a7); return __builtin_bit_cast(bf16x8, w);
}
#define MFMA32(a, b, c) __builtin_amdgcn_mfma_f32_32x32x16_bf16((a), (b), (c), 0, 0, 0)

struct EpiUp {
    static constexpr bool PERM = true, AFTER_DRAIN = false;
    bf16_t* H;
    __device__ __forceinline__ void operator()(const f32x4 (&acc)[2][2][4][2], const pg8::Unit& u, int wr, int wc, int fr, int fq) const {
        const int row0 = u.pm * 256 + wr * 64 + fr, col = u.pn * 128 + wc * 32 + 8 * fq;
#pragma unroll
        for (int ai = 0; ai < 2; ++ai)
#pragma unroll
            for (int m = 0; m < 4; ++m) {
                const f32x4 a0 = acc[ai][0][m][0], a1 = acc[ai][0][m][1], b0 = acc[ai][1][m][0], b1 = acc[ai][1][m][1];
                u32x4 w;
#define SWG(a, b) ((a) * (b) * __builtin_amdgcn_rcpf(1.f + __builtin_amdgcn_exp2f(-(a))))
                w.x = pk2(SWG(a0[0], b0[0]), SWG(a0[1], b0[1])); w.y = pk2(SWG(a0[2], b0[2]), SWG(a0[3], b0[3]));
                w.z = pk2(SWG(a1[0], b1[0]), SWG(a1[1], b1[1])); w.w = pk2(SWG(a1[2], b1[2]), SWG(a1[3], b1[3]));
#undef SWG
                *(u32x4*)(H + (size_t)(row0 + ai * 128 + m * 16) * DFF + col) = w;
            }
    }
};
struct EpiRes {
    static constexpr bool PERM = false, AFTER_DRAIN = false;
    const float* bl; const float* bc; float* ol; float* oc; const float* gate; float gs;
    __device__ __forceinline__ void operator()(const f32x4 (&acc)[2][2][4][2], const pg8::Unit& u, int wr, int wc, int fr, int fq) const {
        const bool lat = u.pm < 128; const int ms = lat ? (u.pm >> 5) : 4;
        const size_t toff = (size_t)(lat ? u.pm : u.pm - 128) * 256 * DM;
        const float* base = (lat ? bl : bc) + toff; float* out = (lat ? ol : oc) + toff;
        const float* g = gate + ms * NMOD; const int col0 = u.pn * 256 + wc * 32 + 4 * fq;
#pragma unroll
        for (int bj = 0; bj < 2; ++bj)
#pragma unroll
            for (int n = 0; n < 2; ++n) {
                const f32x4 gv = *(const f32x4*)(g + col0 + bj * 128 + n * 16) * gs;
                f32x4 b[8];
#pragma unroll
                for (int i = 0; i < 8; ++i) b[i] = *(const f32x4*)(base + (size_t)((i >> 2) * 128 + wr * 64 + (i & 3) * 16 + fr) * DM + col0 + bj * 128 + n * 16);
#pragma unroll
                for (int i = 0; i < 8; ++i) *(f32x4*)(out + (size_t)((i >> 2) * 128 + wr * 64 + (i & 3) * 16 + fr) * DM + col0 + bj * 128 + n * 16) = b[i] + gv * acc[i >> 2][bj][i & 3][n];
                asm volatile("" ::: "memory");
            }
    }
};
template <int MODE> struct EpiBf {
    static constexpr bool PERM = true, AFTER_DRAIN = false;
    bf16_t* O; int ldc; const bf16_t* X; int ldx;
    __device__ __forceinline__ void operator()(const f32x4 (&acc)[2][2][4][2], const pg8::Unit& u, int wr, int wc, int fr, int fq) const {
        const int row0 = u.pm * 256 + wr * 64 + fr, col0 = u.pn * 256 + wc * 32 + 8 * fq;
#pragma unroll
        for (int ai = 0; ai < 2; ++ai)
#pragma unroll
            for (int mh = 0; mh < 2; ++mh) {
                u32x4 cw[4], xw[4];
                if (MODE != 0) {
#pragma unroll
                    for (int i = 0; i < 4; ++i) { const size_t row = (size_t)(row0 + ai * 128 + (2 * mh + (i >> 1)) * 16); const int co = col0 + (i & 1) * 128;
                        cw[i] = *(const u32x4*)(O + row * ldc + co); if (MODE >= 3) xw[i] = *(const u32x4*)(X + row * ldx + co); }
                }
#pragma unroll
                for (int i = 0; i < 4; ++i) {
                    const int m = 2 * mh + (i >> 1), bj = i & 1;
                    bf16_t* p = O + (size_t)(row0 + ai * 128 + m * 16) * ldc + col0 + bj * 128;
                    const f32x4 v0 = acc[ai][bj][m][0], v1 = acc[ai][bj][m][1];
                    float v[8] = {v0[0], v0[1], v0[2], v0[3], v1[0], v1[1], v1[2], v1[3]};
                    if (MODE != 0) {
                        float c[8] = {bf_lo(cw[i].x), bf_hi(cw[i].x), bf_lo(cw[i].y), bf_hi(cw[i].y), bf_lo(cw[i].z), bf_hi(cw[i].z), bf_lo(cw[i].w), bf_hi(cw[i].w)};
                        if (MODE == 1) {
#pragma unroll
                            for (int e = 0; e < 8; ++e) v[e] = v[e] * sigm2(v[e]) * c[e];
                        } else if (MODE == 2) {
#pragma unroll
                            for (int e = 0; e < 8; ++e) v[e] = sigm2(v[e]) * c[e];
                        } else {
                            float x[8] = {bf_lo(xw[i].x), bf_hi(xw[i].x), bf_lo(xw[i].y), bf_hi(xw[i].y), bf_lo(xw[i].z), bf_hi(xw[i].z), bf_lo(xw[i].w), bf_hi(xw[i].w)};
#pragma unroll
                            for (int e = 0; e < 8; ++e) v[e] = (MODE == 4 ? 0.f : c[e]) + sigm2(v[e]) * x[e];
                        }
                    }
                    u32x4 w; w.x = pk2(v[0], v[1]); w.y = pk2(v[2], v[3]); w.z = pk2(v[4], v[5]); w.w = pk2(v[6], v[7]);
                    *(u32x4*)p = w;
                }
                asm volatile("" ::: "memory");
            }
    }
};
template <bool IS_UQ> struct EpiRope {
    static constexpr bool PERM = true, AFTER_DRAIN = false;
    bf16_t* O; const float* rt16c; const float* rt16s; const float* rt8c; const float* rt8s;
    __device__ __forceinline__ void operator()(const f32x4 (&acc)[2][2][4][2], const pg8::Unit& u, int wr, int wc, int fr, int fq) const {
        constexpr int LDC = IS_UQ ? QMW : P1W;
#pragma unroll
        for (int ai = 0; ai < 2; ++ai)
#pragma unroll
            for (int m = 0; m < 4; ++m) {
                const int row = u.pm * 256 + ai * 128 + wr * 64 + m * 16 + fr;
                const bool lat = row < TL; const int t = row & (SEQ - 1), pr = t >> 6, pc = t & 63;
#pragma unroll
                for (int bj = 0; bj < 2; ++bj) {
                    const int cg = (u.pn * 256 + bj * 128 + wc * 32) >> 5;
                    f32x4 v0 = acc[ai][bj][m][0], v1 = acc[ai][bj][m][1];
                    bool r16 = false, r8 = false; float sc = 1.f;
                    if (IS_UQ) { r8 = (cg % 3) == 2; sc = MLA_C2; }
                    else { r16 = cg < 32; r8 = cg == 84; if (cg >= 16 && cg < 32) sc = 0.125f; }
                    if (r16 && lat) {
                        const int pos = (cg & 1) ? pc : pr;
                        const f32x4 cs = *(const f32x4*)(rt16c + pos * 16 + 4 * fq), sn = *(const f32x4*)(rt16s + pos * 16 + 4 * fq);
                        const f32x4 o0 = v0 * cs - v1 * sn, o1 = v1 * cs + v0 * sn; v0 = o0; v1 = o1;
                    }
                    if (r8 && lat) {
                        const int pos = (fq >> 1) ? pc : pr;
                        const f32x4 cs = *(const f32x4*)(rt8c + pos * 8 + 4 * (fq & 1)), sn = *(const f32x4*)(rt8s + pos * 8 + 4 * (fq & 1));
                        const f32x4 o0 = v0 * cs - v1 * sn, o1 = v1 * cs + v0 * sn; v0 = o0; v1 = o1;
                    }
                    v0 = v0 * sc; v1 = v1 * sc;
                    u32x4 w; w.x = pk2(v0[0], v0[1]); w.y = pk2(v0[2], v0[3]); w.z = pk2(v1[0], v1[1]); w.w = pk2(v1[2], v1[3]);
                    *(u32x4*)(O + (size_t)row * LDC + cg * 32 + 8 * fq) = w;
                }
            }
    }
};


struct FinRes { const float* base; float* out; const float* gate; float gs;
    __device__ __forceinline__ void operator()(int r, int c, f32x4 s0, f32x4 s1) const {
        const size_t off = (size_t)r * DM + c;
        const f32x4 g0 = *(const f32x4*)(gate + c) * gs, g1 = *(const f32x4*)(gate + c + 4) * gs;
        const f32x4 x0 = *(const f32x4*)(base + off), x1 = *(const f32x4*)(base + off + 4);
        *(f32x4*)(out + off) = x0 + g0 * s0; *(f32x4*)(out + off + 4) = x1 + g1 * s1; } };
template <int MODE> struct FinBf { bf16_t* O; int ldc; const bf16_t* X; int ldx;
    __device__ __forceinline__ void operator()(int r, int c, f32x4 s0, f32x4 s1) const {
        bf16_t* p = O + (size_t)r * ldc + c;
        float v[8] = {s0[0], s0[1], s0[2], s0[3], s1[0], s1[1], s1[2], s1[3]};
        if (MODE != 0) {
            const u32x4 cw = *(const u32x4*)p;
            float cc[8] = {bf_lo(cw.x), bf_hi(cw.x), bf_lo(cw.y), bf_hi(cw.y), bf_lo(cw.z), bf_hi(cw.z), bf_lo(cw.w), bf_hi(cw.w)};
            if (MODE == 1) {
#pragma unroll
                for (int i = 0; i < 8; ++i) v[i] = v[i] * sigm2(v[i]) * cc[i];
            } else if (MODE == 2) {
#pragma unroll
                for (int i = 0; i < 8; ++i) v[i] = sigm2(v[i]) * cc[i];
            } else {
                const u32x4 xw = *(const u32x4*)(X + (size_t)r * ldx + c);
                float x[8] = {bf_lo(xw.x), bf_hi(xw.x), bf_lo(xw.y), bf_hi(xw.y), bf_lo(xw.z), bf_hi(xw.z), bf_lo(xw.w), bf_hi(xw.w)};
#pragma unroll
                for (int i = 0; i < 8; ++i) v[i] = cc[i] + sigm2(v[i]) * x[i];
            }
        }
        u32x4 w; w.x = pk2(v[0], v[1]); w.y = pk2(v[2], v[3]); w.z = pk2(v[4], v[5]); w.w = pk2(v[6], v[7]);
        *(u32x4*)p = w; } };
template <class Fin> __device__ __forceinline__ void ctx_gemm(const bf16_t* A, int lda, const bf16_t* Bt, int K, const Fin& fin, uchar* lds) {
    const int tid = otid(), lane = tid & 63, wave = tid >> 6, l32 = lane & 31, hi = lane >> 5;
    float* red = (float*)lds;
    const int kw = K >> 3, nst = kw >> 4;
    for (int id = blockIdx.x; id < 256; id += gridDim.x) {
        const int tr = id >> 3, tc = id & 7;
        const bf16_t* ap = A + (size_t)(tr * 32 + l32) * lda + wave * kw + 8 * hi;
        const bf16_t* bp = Bt + (size_t)(tc * 128 + l32) * K + wave * kw + 8 * hi;
        f32x16 acc0 = {}, acc1 = {}, acc2 = {}, acc3 = {};
#pragma unroll 8
        for (int s = 0; s < nst; ++s) {
            const bf16x8 af = *(const bf16x8*)(ap + 16 * s);
            const bf16x8 b0 = *(const bf16x8*)(bp + 16 * s), b1 = *(const bf16x8*)(bp + (size_t)32 * K + 16 * s), b2 = *(const bf16x8*)(bp + (size_t)64 * K + 16 * s), b3 = *(const bf16x8*)(bp + (size_t)96 * K + 16 * s);
            acc0 = MFMA32(af, b0, acc0); acc1 = MFMA32(af, b1, acc1); acc2 = MFMA32(af, b2, acc2); acc3 = MFMA32(af, b3, acc3);
        }
        float* rw = red + wave * 4096 + l32;
#pragma unroll
        for (int r = 0; r < 16; ++r) { float* q = rw + crow(r, hi) * 128; q[0] = acc0[r]; q[32] = acc1[r]; q[64] = acc2[r]; q[96] = acc3[r]; }
        __syncthreads();
        const int row = tid >> 4, c8 = (tid & 15) * 8;
        f32x4 s0 = {}, s1 = {};
#pragma unroll
        for (int w = 0; w < 8; ++w) { s0 += *(const f32x4*)(red + w * 4096 + row * 128 + c8); s1 += *(const f32x4*)(red + w * 4096 + row * 128 + c8 + 4); }
        fin(tr * 32 + row, tc * 128 + c8, s0, s1);
        __syncthreads();
    }
}
__device__ __forceinline__ void sincos_d(double x, double& s, double& c) {
    const double TWO_PI = 6.283185307179586476925;
    const double k = rint(x / TWO_PI); const double r = x - k * TWO_PI; const double r2 = r * r;
    double ss = 1.0, cc = 1.0;
#pragma unroll
    for (int n = 15; n >= 1; --n) { ss = 1.0 - r2 / (double)((2 * n) * (2 * n + 1)) * ss; cc = 1.0 - r2 / (double)((2 * n - 1) * (2 * n)) * cc; }
    s = r * ss; c = cc;
}
__device__ __forceinline__ void phase_mods(const KArgs& a, uchar* lds) {
    const int tid = otid(), lane = tid & 63, wave = tid >> 6;
    float* sm = (float*)lds; float* red = sm + 5 * 1024;
    for (int idx = tid; idx < 5 * 1024; idx += 512) { const int ms = idx >> 10, k = idx & 1023; const float c = ms < 4 ? a.in[1][ms * 1024 + k] : a.in[3][k]; sm[idx] = c / (1.f + expf(-c)); }
    __syncthreads();
    float* mod = (float*)(a.ws + WS_MOD);
    for (int item = blockIdx.x; item < 288; item += gridDim.x) {
        const int l = item / 144, j = (item % 144) * 64 + lane;
        const float* w = a.in[4] + (size_t)l * 1024 * NMOD + j;
        float acc[5] = {0.f, 0.f, 0.f, 0.f, 0.f};
#pragma unroll 32
        for (int kk = 0; kk < 128; ++kk) { const int k = wave * 128 + kk; const float wv = w[(size_t)k * NMOD];
#pragma unroll
            for (int ms = 0; ms < 5; ++ms) acc[ms] += sm[ms * 1024 + k] * wv; }
#pragma unroll
        for (int ms = 0; ms < 5; ++ms) red[(wave * 5 + ms) * 64 + lane] = acc[ms];
        __syncthreads();
        if (wave == 0) {
#pragma unroll
            for (int ms = 0; ms < 5; ++ms) { float s = 0.f;
#pragma unroll
                for (int w8 = 0; w8 < 8; ++w8) s += red[(w8 * 5 + ms) * 64 + lane];
                mod[(size_t)(l * 5 + ms) * NMOD + j] = s + a.in[5][l * NMOD + j]; }
        }
        __syncthreads();
    }
    float* rt = (float*)(a.ws + WS_ROPE);
    for (int idx = blockIdx.x * 512 + tid; idx < 128 * 24; idx += gridDim.x * 512) {
        const int pos = idx / 24, f = idx % 24;
        const float invf = f < 16 ? exp2f(-(float)f * (13.287712379549449f / 16.f)) : exp2f(-(float)(f - 16) * (13.287712379549449f / 8.f));
        const float ang = (float)pos * invf; double s, c; sincos_d((double)ang, s, c);
        if (f < 16) { rt[pos * 16 + f] = (float)c; rt[2048 + pos * 16 + f] = (float)s; }
        else { rt[4096 + pos * 8 + (f - 16)] = (float)c; rt[5120 + pos * 8 + (f - 16)] = (float)s; }
    }
}
__device__ __forceinline__ int rope16_perm(int p) { return 32 * (p >> 5) + 16 * ((p >> 2) & 1) + 4 * ((p >> 3) & 3) + (p & 3); }
__device__ __forceinline__ int rope8_perm(int p) { const int fq = p >> 3; return 16 * (fq >> 1) + 8 * ((p >> 2) & 1) + 4 * (fq & 1) + (p & 3); }
template <int MODE> __device__ __forceinline__ void conv_item(const float* W, const float* W2, int Nsrc, int N, int Kd, int coff, bf16_t* WT, float* scr, int item, int lane, float wscale = 1.f) {
    const int nblk = N / 32, kb = item / nblk, nb = item % nblk, k0 = 64 * kb, n0 = 32 * nb;
    const int j = n0 + (lane & 31);
    const float* Wp = W; int sc;
    if (MODE == 0) sc = coff + j;
    else if (MODE == 1) { const int jj = j & 255; Wp = jj < 128 ? W : W2; sc = 128 * (j >> 8) + (jj & 127); }
    else if (MODE == 2) {
        if (j < 1024) sc = (j >> 9) * 512 + ((j >> 6) & 7) * 64 + rope16_perm(j & 63);
        else if (j < 2048) sc = j;
        else if (j < 2432) sc = 3072 + (j - 2048);
        else if (j < 2688) sc = 3456 + (j - 2432);
        else if (j < 2720) sc = 3712 + rope8_perm(j - 2688);
        else sc = -1;
    } else if (MODE == 3) { const int hd = j / 96, d = j % 96; sc = hd * 96 + (d < 64 ? d : 64 + rope8_perm(d - 64)); }
    else if (MODE == 4) { if (j < 512) sc = (j >> 6) * 128 + (j & 63); else { const int jj = j - 512; sc = (jj >> 6) * 128 + 64 + (jj & 63); } }
    else sc = j;
#pragma unroll
    for (int i = 0; i < 32; ++i) {
        const int kk = 2 * i + (lane >> 5); int ks = k0 + kk;
        if (MODE == 5) { const int hd = ks / 96, d = ks % 96; ks = d < 64 ? hd * 64 + d : -1; }
        float v = 0.f; if (sc >= 0 && ks >= 0) v = Wp[(size_t)ks * Nsrc + sc];
        if (MODE == 0) v *= wscale;
        if (MODE == 1) v *= ((j & 255) < 128) ? LOG2E : (1.f / LOG2E);
        scr[kk * 33 + (lane & 31)] = v;
    }
    asm volatile("s_waitcnt lgkmcnt(0)" ::: "memory");
    const int c = lane & 7;
#pragma unroll
    for (int q = 0; q < 4; ++q) { const int n = (lane >> 3) + 8 * q; const float* s = scr + (8 * c) * 33 + n;
        u32x4 o; o.x = pk2(s[0], s[33]); o.y = pk2(s[66], s[99]); o.z = pk2(s[132], s[165]); o.w = pk2(s[198], s[231]);
        *(u32x4*)(WT + (size_t)(n0 + n) * Kd + k0 + 8 * c) = o; }
    asm volatile("s_waitcnt lgkmcnt(0)" ::: "memory");
}
__device__ __forceinline__ void phase_conv(const KArgs& a, uchar* lds, int l) {
    const int tid = otid(), lane = tid & 63, wave = tid >> 6;
    float* scr = (float*)(lds + wave * 16384);
    bf16_t* WB = (bf16_t*)(a.ws + WS_W);
    const int gw = blockIdx.x * 8 + wave, NGW = gridDim.x * 8;
    const float* f1w1 = a.in[6] + (size_t)l * DM * DFF; const float* f1w3 = a.in[7] + (size_t)l * DM * DFF; const float* f1w2 = a.in[8] + (size_t)l * DFF * DM;
    const float* f2w1 = a.in[9] + (size_t)l * DM * DFF; const float* f2w3 = a.in[10] + (size_t)l * DM * DFF; const float* f2w2 = a.in[11] + (size_t)l * DFF * DM;
    const float* win = a.in[12] + (size_t)l * DM * INW;
    const float* wuq = a.in[18] + (size_t)l * 384 * 768; const float* wukv = a.in[19] + (size_t)l * 256 * 1024;
    const float* wro = a.in[20] + (size_t)l * 1024 * 1024; const float* wmo = a.in[21] + (size_t)l * 512 * 1024; const float* wo = a.in[22] + (size_t)l * 1024 * 1024;
    constexpr int I_UP = 176 * 16, I_DN = 32 * 44, I_IN = 88 * 16, I_G = 32 * 16, I_UQ = 24 * 6, I_UKV = 32 * 4, I_MO = 32 * 8;
    constexpr int NIT = 2 * I_UP + 2 * I_DN + I_IN + 3 * I_G + I_UQ + I_UKV + I_G + I_MO + I_G;
    for (int it = gw; it < NIT; it += NGW) {
        int r = it;
        if (r < I_UP) { conv_item<1>(f1w1, f1w3, DFF, 5632, 1024, 0, WB + WE_UP1, scr, r, lane); continue; } r -= I_UP;
        if (r < I_DN) { conv_item<0>(f1w2, nullptr, DM, 1024, DFF, 0, WB + WE_DN1, scr, r, lane); continue; } r -= I_DN;
        if (r < I_UP) { conv_item<1>(f2w1, f2w3, DFF, 5632, 1024, 0, WB + WE_UP2, scr, r, lane); continue; } r -= I_UP;
        if (r < I_DN) { conv_item<0>(f2w2, nullptr, DM, 1024, DFF, 0, WB + WE_DN2, scr, r, lane); continue; } r -= I_DN;
        if (r < I_IN) { conv_item<2>(win, nullptr, INW, P1W, 1024, 0, WB + WE_IN, scr, r, lane); continue; } r -= I_IN;
        if (r < I_G) { conv_item<0>(win, nullptr, INW, 1024, 1024, 2048, WB + WE_G, scr, r, lane, LOG2E); continue; } r -= I_G;
        if (r < I_G) { conv_item<0>(win, nullptr, INW, 1024, 1024, 3744, WB + WE_GR, scr, r, lane, LOG2E); continue; } r -= I_G;
        if (r < I_G) { conv_item<0>(win, nullptr, INW, 1024, 1024, 4768, WB + WE_GM, scr, r, lane, LOG2E); continue; } r -= I_G;
        if (r < I_UQ) { conv_item<3>(wuq, nullptr, 768, 768, 384, 0, WB + WE_UQ, scr, r, lane); continue; } r -= I_UQ;
        if (r < I_UKV) { conv_item<4>(wukv, nullptr, 1024, 1024, 256, 0, WB + WE_UKV, scr, r, lane); continue; } r -= I_UKV;
        if (r < I_G) { conv_item<0>(wro, nullptr, 1024, 1024, 1024, 0, WB + WE_RO, scr, r, lane); continue; } r -= I_G;
        if (r < I_MO) { conv_item<0>(wmo, nullptr, 1024, 1024, 512, 0, WB + WE_MO, scr, r, lane); continue; } r -= I_MO;
        conv_item<0>(wo, nullptr, 1024, 1024, 1024, 0, WB + WE_WO, scr, r, lane);
    }
}
__device__ __forceinline__ void phase_norm(const float* xl, const float* xc, const float* mod, int shoff, bf16_t* XN, int M = MR) {
    const int tid = otid(), lane = tid & 63, gw = blockIdx.x * 8 + (tid >> 6), NGW = gridDim.x * 8;
    for (int row0 = gw; row0 < M; row0 += 2 * NGW) {
        const int row1 = row0 + NGW; const bool has1 = row1 < M;
        const float* src0 = row0 < TL ? xl + (size_t)row0 * DM : xc + (size_t)(row0 - TL) * DM;
        const float* src1 = has1 ? (row1 < TL ? xl + (size_t)row1 * DM : xc + (size_t)(row1 - TL) * DM) : src0;
        f32x4 v0[4], v1[4]; float s0 = 0.f, s1 = 0.f;
#pragma unroll
        for (int j = 0; j < 4; ++j) { v0[j] = *(const f32x4*)(src0 + 4 * lane + 256 * j); v1[j] = *(const f32x4*)(src1 + 4 * lane + 256 * j); }
#pragma unroll
        for (int j = 0; j < 4; ++j) { s0 += (v0[j].x * v0[j].x + v0[j].y * v0[j].y) + (v0[j].z * v0[j].z + v0[j].w * v0[j].w); s1 += (v1[j].x * v1[j].x + v1[j].y * v1[j].y) + (v1[j].z * v1[j].z + v1[j].w * v1[j].w); }
        const float r0 = 1.f / sqrtf(wave_sum(s0) * (1.f / DM) + EPSN), r1 = 1.f / sqrtf(wave_sum(s1) * (1.f / DM) + EPSN);
        const float* mp0 = mod + (row0 < TL ? (row0 >> 13) : 4) * NMOD + shoff; const float* mp1 = mod + (row1 < TL ? (row1 >> 13) : 4) * NMOD + shoff;
#pragma unroll
        for (int j = 0; j < 4; ++j) {
            const f32x4 sh = *(const f32x4*)(mp0 + 4 * lane + 256 * j), sc = *(const f32x4*)(mp0 + DM + 4 * lane + 256 * j);
            const f32x4 o = v0[j] * r0 * (sc + 1.f) + sh; u32x2 w; w.x = pk2(o.x, o.y); w.y = pk2(o.z, o.w);
            *(u32x2*)(XN + (size_t)row0 * DM + 4 * lane + 256 * j) = w;
        }
        if (has1) {
#pragma unroll
            for (int j = 0; j < 4; ++j) {
                const f32x4 sh = *(const f32x4*)(mp1 + 4 * lane + 256 * j), sc = *(const f32x4*)(mp1 + DM + 4 * lane + 256 * j);
                const f32x4 o = v1[j] * r1 * (sc + 1.f) + sh; u32x2 w; w.x = pk2(o.x, o.y); w.y = pk2(o.z, o.w);
                *(u32x2*)(XN + (size_t)row1 * DM + 4 * lane + 256 * j) = w;
            }
        }
    }
}
__device__ __forceinline__ void phase_final_norm(float* x, const float* gain) {
    const int tid = otid(), lane = tid & 63, gw = blockIdx.x * 8 + (tid >> 6), NGW = gridDim.x * 8;
    for (int row0 = gw; row0 < TL; row0 += 2 * NGW) {
        const int row1 = row0 + NGW; const bool has1 = row1 < TL;
        float* p0 = x + (size_t)row0 * DM; float* p1 = has1 ? x + (size_t)row1 * DM : p0;
        f32x4 v0[4], v1[4]; float s0 = 0.f, s1 = 0.f;
#pragma unroll
        for (int j = 0; j < 4; ++j) { v0[j] = *(const f32x4*)(p0 + 4 * lane + 256 * j); v1[j] = *(const f32x4*)(p1 + 4 * lane + 256 * j); }
#pragma unroll
        for (int j = 0; j < 4; ++j) { s0 += (v0[j].x * v0[j].x + v0[j].y * v0[j].y) + (v0[j].z * v0[j].z + v0[j].w * v0[j].w); s1 += (v1[j].x * v1[j].x + v1[j].y * v1[j].y) + (v1[j].z * v1[j].z + v1[j].w * v1[j].w); }
        const float r0 = 1.f / sqrtf(wave_sum(s0) * (1.f / DM) + EPSN), r1 = 1.f / sqrtf(wave_sum(s1) * (1.f / DM) + EPSN);
#pragma unroll
        for (int j = 0; j < 4; ++j) { const f32x4 g = *(const f32x4*)(gain + 4 * lane + 256 * j); *(f32x4*)(p0 + 4 * lane + 256 * j) = v0[j] * r0 * g; if (has1) *(f32x4*)(p1 + 4 * lane + 256 * j) = v1[j] * r1 * g; }
    }
}
__device__ __forceinline__ void phase_mla_prep(bf16_t* P1, const float* qn, const float* kvn) {
    const int tid = otid(), lane = tid & 63, gw = blockIdx.x * 8 + (tid >> 6), NGW = gridDim.x * 8;
    f32x4 gq0 = {}, gq1 = {}, gk0 = {}, gk1 = {};
    if (lane < 48) { gq0 = *(const f32x4*)(qn + 8 * lane); gq1 = *(const f32x4*)(qn + 8 * lane + 4); }
    if (lane < 32) { gk0 = *(const f32x4*)(kvn + 8 * lane); gk1 = *(const f32x4*)(kvn + 8 * lane + 4); }
    for (int rowb = gw; rowb < MR; rowb += 4 * NGW) {
        u32x4 wq[4], wk[4];
#pragma unroll
        for (int i = 0; i < 4; ++i) { const int row = rowb + i * NGW; wq[i] = (u32x4){0u, 0u, 0u, 0u}; wk[i] = wq[i];
            if (row < MR) { if (lane < 48) wq[i] = *(const u32x4*)(P1 + (size_t)row * P1W + 2048 + 8 * lane); if (lane < 32) wk[i] = *(const u32x4*)(P1 + (size_t)row * P1W + 2432 + 8 * lane); } }
#pragma unroll
        for (int i = 0; i < 4; ++i) { const int row = rowb + i * NGW;
            float q[8] = {bf_lo(wq[i].x), bf_hi(wq[i].x), bf_lo(wq[i].y), bf_hi(wq[i].y), bf_lo(wq[i].z), bf_hi(wq[i].z), bf_lo(wq[i].w), bf_hi(wq[i].w)};
            float k[8] = {bf_lo(wk[i].x), bf_hi(wk[i].x), bf_lo(wk[i].y), bf_hi(wk[i].y), bf_lo(wk[i].z), bf_hi(wk[i].z), bf_lo(wk[i].w), bf_hi(wk[i].w)};
            float sq = 0.f, sk = 0.f;
#pragma unroll
            for (int e = 0; e < 8; ++e) { sq += q[e] * q[e]; sk += k[e] * k[e]; }
            const float rq = 1.f / sqrtf(wave_sum(sq) * (1.f / 384.f) + EPSN), rk = 1.f / sqrtf(wave_sum(sk) * (1.f / 256.f) + EPSN);
            if (row < MR) {
                if (lane < 48) { u32x4 o; o.x = pk2(q[0] * rq * gq0.x, q[1] * rq * gq0.y); o.y = pk2(q[2] * rq * gq0.z, q[3] * rq * gq0.w); o.z = pk2(q[4] * rq * gq1.x, q[5] * rq * gq1.y); o.w = pk2(q[6] * rq * gq1.z, q[7] * rq * gq1.w);
                    *(u32x4*)(P1 + (size_t)row * P1W + 2048 + 8 * lane) = o; }
                if (lane < 32) { u32x4 o; o.x = pk2(k[0] * rk * gk0.x, k[1] * rk * gk0.y); o.y = pk2(k[2] * rk * gk0.z, k[3] * rk * gk0.w); o.z = pk2(k[4] * rk * gk1.x, k[5] * rk * gk1.y); o.w = pk2(k[6] * rk * gk1.z, k[7] * rk * gk1.w);
                    *(u32x4*)(P1 + (size_t)row * P1W + 2432 + 8 * lane) = o; }
            }
        }
    }
}

constexpr int TS = 272;
__device__ __forceinline__ void tstore_pair(uchar* T, int stride, int posb, int c8, u32x4 r0, u32x4 r1, int sw = 0) {
    uchar* p = T + (size_t)(8 * c8) * stride + posb * 2; (void)sw;
    *(unsigned*)(p + 0 * stride) = (r0.x & 0xffffu) | (r1.x << 16); *(unsigned*)(p + 1 * stride) = (r0.x >> 16) | (r1.x & 0xffff0000u);
    *(unsigned*)(p + 2 * stride) = (r0.y & 0xffffu) | (r1.y << 16); *(unsigned*)(p + 3 * stride) = (r0.y >> 16) | (r1.y & 0xffff0000u);
    *(unsigned*)(p + 4 * stride) = (r0.z & 0xffffu) | (r1.z << 16); *(unsigned*)(p + 5 * stride) = (r0.z >> 16) | (r1.z & 0xffff0000u);
    *(unsigned*)(p + 6 * stride) = (r0.w & 0xffffu) | (r1.w << 16); *(unsigned*)(p + 7 * stride) = (r0.w >> 16) | (r1.w & 0xffff0000u);
}
__device__ __forceinline__ u32x4 scale8(u32x4 w, float s) {
    u32x4 o; o.x = pk2(bf_lo(w.x) * s, bf_hi(w.x) * s); o.y = pk2(bf_lo(w.y) * s, bf_hi(w.y) * s); o.z = pk2(bf_lo(w.z) * s, bf_hi(w.z) * s); o.w = pk2(bf_lo(w.w) * s, bf_hi(w.w) * s); return o;
}
__device__ __forceinline__ void phase_r1(const bf16_t* P1, bf16_t* ST, bf16_t* CT, const float* dfw, const float* dbw, uchar* lds) {
    const int tid = otid(), lane = tid & 63, wave = tid >> 6, l32 = lane & 31, hi = lane >> 5;
    uchar* Tv = lds; uchar* Tkf = lds + 128 * TS; uchar* Tkb = Tkf + 64 * TS;
    const int kpa = tid >> 3, kc8 = tid & 7, j0 = 2 * kpa;
    u32x4 rv[4], rk[2];
#define R1_ROWS(u) ((u) < 2048 ? ((u) >> 9) * SEQ + ((u) & 63) * 128 : TL + (((u) - 2048) >> 4) * LCTX + (((u) - 2048) & 1) * 128)
#define R1_HEAD(u) ((u) < 2048 ? (((u) >> 6) & 7) : ((((u) - 2048) >> 1) & 7))
#define R1_LOAD(u) do { const int rows_ = R1_ROWS(u), h_ = R1_HEAD(u); const bf16_t* kp_ = P1 + (size_t)rows_ * P1W + 512 + h_ * 64; const bf16_t* vp_ = P1 + (size_t)rows_ * P1W + 1024 + h_ * 128; \
        _Pragma("unroll") for (int i = 0; i < 2; ++i) { const int task = tid + 512 * i, pa = task >> 4, c8 = task & 15; \
            rv[2 * i] = *(const u32x4*)(vp_ + (size_t)(2 * pa) * P1W + 8 * c8); rv[2 * i + 1] = *(const u32x4*)(vp_ + (size_t)(2 * pa + 1) * P1W + 8 * c8); } \
        rk[0] = *(const u32x4*)(kp_ + (size_t)j0 * P1W + 8 * kc8); rk[1] = *(const u32x4*)(kp_ + (size_t)(j0 + 1) * P1W + 8 * kc8); } while (0)
    int u = blockIdx.x;
    if (u < 2112) R1_LOAD(u);
    for (; u < 2112; u += gridDim.x) {
        int b, h; bf16_t* dstf; bf16_t* dstb;
        if (u < 2048) { b = u >> 9; h = (u >> 6) & 7; const int n = u & 63;
            dstf = ST + ((size_t)((0 * 4 + b) * 8 + h) * 64 + n) * 8192; dstb = ST + ((size_t)((1 * 4 + b) * 8 + h) * 64 + n) * 8192; }
        else { const int uc = u - 2048; b = uc >> 4; h = (uc >> 1) & 7; const int nc = uc & 1;
            dstf = CT + ((size_t)((0 * 4 + b) * 8 + h) * 2 + nc) * 8192; dstb = CT + ((size_t)((1 * 4 + b) * 8 + h) * 2 + nc) * 8192; }
        const float lgf = -expf(dfw[h]) * LOG2E, lgb = -expf(dbw[h]) * LOG2E;
#pragma unroll
        for (int i = 0; i < 2; ++i) { const int task = tid + 512 * i, pa = task >> 4, c8 = task & 15; tstore_pair(Tv, TS, (2 * pa & 64) + pos64(2 * pa & 63), c8, rv[2 * i], rv[2 * i + 1], c8); }
        { const int posb = (j0 & 64) + pos64(j0 & 63);
            tstore_pair(Tkf, TS, posb, kc8, scale8(rk[0], ex2(lgf * (float)(127 - j0))), scale8(rk[1], ex2(lgf * (float)(126 - j0))), kc8);
            tstore_pair(Tkb, TS, posb, kc8, scale8(rk[0], ex2(lgb * (float)j0)), scale8(rk[1], ex2(lgb * (float)(j0 + 1))), kc8); }
        __syncthreads();
        if (u + (int)gridDim.x < 2112) R1_LOAD(u + (int)gridDim.x);
        const int dir = wave >> 2, dvb = wave & 3;
        const uchar* Tk = dir ? Tkb : Tkf;
        f32x16 acc0 = {}, acc1 = {};
#pragma unroll
        for (int kk = 0; kk < 8; ++kk) {
            const bf16x8 av = *(const bf16x8*)(Tv + (dvb * 32 + l32) * TS + (16 * kk + 8 * hi) * 2);
            const bf16x8 b0 = *(const bf16x8*)(Tk + l32 * TS + (16 * kk + 8 * hi) * 2), b1 = *(const bf16x8*)(Tk + (32 + l32) * TS + (16 * kk + 8 * hi) * 2);
            acc0 = MFMA32(av, b0, acc0); acc1 = MFMA32(av, b1, acc1);
        }
        bf16_t* dst = dir ? dstb : dstf;
#pragma unroll
        for (int r = 0; r < 16; ++r) { bf16_t* p = dst + (dvb * 32 + crow(r, hi)) * 64 + l32; p[0] = (bf16_t)(pk2(acc0[r], 0.f) & 0xffffu); p[32] = (bf16_t)(pk2(acc1[r], 0.f) & 0xffffu); }
        __syncthreads();
    }
#undef R1_ROWS
#undef R1_HEAD
#undef R1_LOAD
}
__device__ __forceinline__ void phase_scan(bf16_t* ST, const bf16_t* CT, const float* dfw, const float* dbw, bool nostore = false) {
    const int gt = blockIdx.x * 512 + otid(), NT = gridDim.x * 512;
    for (int task = gt; task < 2 * 4 * 8 * 4096; task += NT) {
        const int e2 = task & 4095, bh = (task >> 12) & 31, dir = task >> 17, h = bh & 7;
        const float gC = ex2(-expf((dir ? dbw : dfw)[h]) * LOG2E * 128.f);
        unsigned* st = (unsigned*)(ST + ((size_t)(dir * 32 + bh) * 64) * 8192) + e2;
        const unsigned* ct = (const unsigned*)(CT + ((size_t)(dir * 32 + bh) * 2) * 8192) + e2;
        const unsigned c0 = ct[0], c1 = ct[4096];
        float s0, s1;
        if (dir == 0) { s0 = gC * bf_lo(c0) + bf_lo(c1); s1 = gC * bf_hi(c0) + bf_hi(c1); }
        else { s0 = gC * bf_lo(c1) + bf_lo(c0); s1 = gC * bf_hi(c1) + bf_hi(c0); }
#pragma unroll 16
        for (int step = 0; step < 64; ++step) {
            const int n = dir ? 63 - step : step;
            const unsigned t = st[(size_t)n * 4096];
            if (!nostore) st[(size_t)n * 4096] = pk2(s0, s1); else if (s0 == 123.456f) st[0] = 0u;
            s0 = gC * s0 + bf_lo(t); s1 = gC * s1 + bf_hi(t);
        }
    }
}
__device__ __forceinline__ void phase_r3(bf16_t* P1, const bf16_t* ST, const bf16_t* CT, const float* dfw, const float* dbw, const float* gn, uchar* lds, bool with_ctx, bool nostore = false) {
    const int tid = otid(), lane = tid & 63, wave = tid >> 6, l32 = lane & 31, hi = lane >> 5, grp = wave >> 2, ib = wave & 3, tg = tid & 255;
    uchar* Tv = lds + grp * (128 * TS);
    const int nunits = with_ctx ? 2112 : 2048, npairs = nunits / 2;
    for (int it = blockIdx.x; it < npairs; it += gridDim.x) {
        const int u = 2 * it + grp;
        int b, h, rows0; const bf16_t* stf; const bf16_t* stb;
        if (u < 2048) { b = u >> 9; h = (u >> 6) & 7; const int n = u & 63; rows0 = b * SEQ + n * 128;
            stf = ST + ((size_t)((0 * 4 + b) * 8 + h) * 64 + n) * 8192; stb = ST + ((size_t)((1 * 4 + b) * 8 + h) * 64 + n) * 8192; }
        else { const int uc = u - 2048; b = uc >> 4; h = (uc >> 1) & 7; const int nc = uc & 1; rows0 = TL + b * LCTX + nc * 128;
            stf = nc == 1 ? CT + ((size_t)((0 * 4 + b) * 8 + h) * 2 + 0) * 8192 : nullptr; stb = nc == 0 ? CT + ((size_t)((1 * 4 + b) * 8 + h) * 2 + 1) * 8192 : nullptr; }
        const float lgf = -expf(dfw[h]) * LOG2E, lgb = -expf(dbw[h]) * LOG2E;
        bf16_t* qp = P1 + (size_t)rows0 * P1W + h * 64; const bf16_t* kp = qp + 512; bf16_t* vp = P1 + (size_t)rows0 * P1W + 1024 + h * 128;
#pragma unroll
        for (int i = 0; i < 4; ++i) { const int task = tg + 256 * i, pa = task >> 4, c8 = task & 15;
            const u32x4 r0 = *(const u32x4*)(vp + (size_t)(2 * pa) * P1W + 8 * c8), r1 = *(const u32x4*)(vp + (size_t)(2 * pa + 1) * P1W + 8 * c8);
            tstore_pair(Tv, TS, (2 * pa & 64) + pos64(2 * pa & 63), c8, r0, r1, c8); }
        __syncthreads();
        int il_ = ib * 32 + l32; asm volatile("" : "+v"(il_)); const int il = il_;
        bf16x8 qf[4];
#pragma unroll
        for (int s = 0; s < 4; ++s) qf[s] = *(const bf16x8*)(qp + (size_t)il * P1W + 16 * s + 8 * hi);
        f32x16 sT[4];
#pragma unroll
        for (int jb = 0; jb < 4; ++jb) { sT[jb] = (f32x16){};
#pragma unroll
            for (int s = 0; s < 4; ++s) { const bf16x8 kf = *(const bf16x8*)(kp + (size_t)(jb * 32 + l32) * P1W + 16 * s + 8 * hi); sT[jb] = MFMA32(kf, qf[s], sT[jb]); }
            if (jb & 1) asm volatile("" ::: "memory"); }
        const float fdl = (float)(il - 4 * hi);
#pragma unroll
        for (int jb = 0; jb < 4; ++jb)
#pragma unroll
            for (int r = 0; r < 16; ++r) { const float fd = fdl - (float)(jb * 32 + (r & 3) + 8 * (r >> 2));
                const float e = ex2(fd * (fd > 0.f ? lgf : -lgb)); sT[jb][r] *= (fd == 0.f ? 2.f : e); }
        f32x16 oT[4] = {};
#pragma unroll
        for (int kk = 0; kk < 8; ++kk) {
            const int jb = kk >> 1, r0 = 8 * (kk & 1);
            const bf16x8 pf = pack8(sT[jb][r0], sT[jb][r0 + 1], sT[jb][r0 + 2], sT[jb][r0 + 3], sT[jb][r0 + 4], sT[jb][r0 + 5], sT[jb][r0 + 6], sT[jb][r0 + 7]);
#pragma unroll
            for (int dvb = 0; dvb < 4; ++dvb) { const bf16x8 av = *(const bf16x8*)(Tv + (dvb * 32 + l32) * TS + (16 * kk + 8 * hi) * 2); oT[dvb] = MFMA32(av, pf, oT[dvb]); }
            if (kk & 1) asm volatile("" ::: "memory");
        }
#pragma unroll
        for (int dir = 0; dir < 2; ++dir) {
            const bf16_t* sp = dir ? stb : stf;
#ifdef R3_NO_CROSS
            sp = nullptr;
#endif
            if (sp) {
                const float dec = dir ? ex2(lgb * (float)(128 - il)) : ex2(lgf * (float)(il + 1));
#pragma unroll
                for (int s = 0; s < 4; ++s) {
                    const bf16x8 qd = __builtin_bit_cast(bf16x8, scale8(__builtin_bit_cast(u32x4, qf[s]), dec));
#pragma unroll
                    for (int dvb = 0; dvb < 4; ++dvb) { const bf16x8 av = *(const bf16x8*)(sp + (dvb * 32 + l32) * 64 + 16 * s + 8 * hi); oT[dvb] = MFMA32(av, qd, oT[dvb]); }
                    if (s & 1) asm volatile("" ::: "memory");
                }
            }
        }
        float sm = 0.f;
#pragma unroll
        for (int dvb = 0; dvb < 4; ++dvb)
#pragma unroll
            for (int r = 0; r < 16; ++r) sm += oT[dvb][r];
        sm += __shfl_xor(sm, 32); const float mu = sm * (1.f / 128.f);
        float sq = 0.f;
#pragma unroll
        for (int dvb = 0; dvb < 4; ++dvb)
#pragma unroll
            for (int r = 0; r < 16; ++r) { const float d = oT[dvb][r] - mu; sq += d * d; }
        sq += __shfl_xor(sq, 32); const float rstd = 1.f / sqrtf(sq * (1.f / 128.f) + EPSN);
        const float* gp = gn + h * 128;
#pragma unroll
        for (int dvb = 0; dvb < 4; ++dvb)
#pragma unroll
            for (int rq = 0; rq < 4; ++rq) { const int dv = 32 * dvb + 8 * rq + 4 * hi; const f32x4 g = *(const f32x4*)(gp + dv) * (1.f / LOG2E);
                u32x2 w; w.x = pk2((oT[dvb][4 * rq] - mu) * rstd * g.x, (oT[dvb][4 * rq + 1] - mu) * rstd * g.y); w.y = pk2((oT[dvb][4 * rq + 2] - mu) * rstd * g.z, (oT[dvb][4 * rq + 3] - mu) * rstd * g.w);
                if (!nostore || w.x == 0x12345678u) *(u32x2*)(vp + (size_t)il * P1W + dv) = w; if (rq == 3) asm volatile("" ::: "memory"); }
        __syncthreads();
    }
}

constexpr int KROW = 208, VROW = 144, KT_BYTES = 64 * KROW, VT_BYTES = 64 * VROW;
__device__ __forceinline__ void attn_unit(const bf16_t* Qm, const bf16_t* KVm, const bf16_t* P1, bf16_t* OP, int q0, int h, int klat, int nlat, int kctx, int nt, uchar* lds) {
    const int tid = otid(), lane = tid & 63, wave = tid >> 6, l32 = lane & 31, hi = lane >> 5;
    uchar* Kt = lds; uchar* Vt = lds + 2 * KT_BYTES;
    const bf16_t* qrow = Qm + (size_t)(q0 + wave * 32 + l32) * QMW + h * 96;
    bf16_t* orow = OP + (size_t)(q0 + wave * 32 + l32) * P1W + 2048 + h * 64;
    bf16x8 qf[6];
#pragma unroll
    for (int s = 0; s < 6; ++s) qf[s] = *(const bf16x8*)(qrow + 16 * s + 8 * hi);
    const int kr0 = tid / 12, kc0 = tid % 12, kr1 = (512 + tid) / 12, kc1 = (512 + tid) % 12;
    const int tv = tid - 256, va = tv >> 3, vc8 = tv & 7;
    u32x4 xk0, xa = (u32x4){0u, 0u, 0u, 0u}, xb = xa;
#define TILE_ROW(j) ((j) < nlat ? klat + 64 * (j) : kctx + 64 * ((j) - nlat))
#define LOADK(j) do { const int kb_ = TILE_ROW(j); \
        xk0 = kc0 < 8 ? *(const u32x4*)(KVm + (size_t)(kb_ + kr0) * KVW + h * 64 + 8 * kc0) : *(const u32x4*)(P1 + (size_t)(kb_ + kr0) * P1W + 2688 + 8 * (kc0 - 8)); \
        if (tid < 256) { xa = kc1 < 8 ? *(const u32x4*)(KVm + (size_t)(kb_ + kr1) * KVW + h * 64 + 8 * kc1) : *(const u32x4*)(P1 + (size_t)(kb_ + kr1) * P1W + 2688 + 8 * (kc1 - 8)); } } while (0)
#define LOADV(j) do { if (tid >= 256) { const int kb_ = TILE_ROW(j); \
        xa = *(const u32x4*)(KVm + (size_t)(kb_ + 2 * va) * KVW + 512 + h * 64 + 8 * vc8); xb = *(const u32x4*)(KVm + (size_t)(kb_ + 2 * va + 1) * KVW + 512 + h * 64 + 8 * vc8); } } while (0)
#define STOREK(buf) do { *(u32x4*)(Kt + (buf) * KT_BYTES + kr0 * KROW + kc0 * 16) = xk0; if (tid < 256) { *(u32x4*)(Kt + (buf) * KT_BYTES + kr1 * KROW + kc1 * 16) = xa; } } while (0)
#define STOREV(buf) do { if (tid >= 256) { tstore_pair(Vt + (buf) * VT_BYTES, VROW, pos64(2 * va), vc8, xa, xb); } } while (0)
    LOADK(0); LOADV(0); STOREK(0); STOREV(0); LOADK(1); STOREK(1);
    __syncthreads();
    f32x16 negm = {}, s0 = {}, s1 = {};
    { const uchar* kb = Kt + l32 * KROW + hi * 16;
#pragma unroll
      for (int s = 0; s < 6; ++s) { const bf16x8 a0 = *(const bf16x8*)(kb + s * 32), a1 = *(const bf16x8*)(kb + 32 * KROW + s * 32); s0 = MFMA32(a0, qf[s], s0); s1 = MFMA32(a1, qf[s], s1); } }
    __syncthreads();
    float mref = 0.f, lsum = 0.f; f32x16 o0 = {}, o1 = {};
    for (int t = 0; t < nt; ++t) {
        const int buf = t & 1;
        if (t + 2 < nt) LOADK(t + 2);
        if (t + 1 < nt) LOADV(t + 1);
        float ra = fmaxf(fmaxf(s0[0], s0[1]), s1[0]), rb = fmaxf(fmaxf(s0[2], s0[3]), s1[1]); ra = fmaxf(fmaxf(ra, s1[2]), s1[3]);
#pragma unroll
        for (int r = 4; r < 16; r += 4) { ra = fmaxf(fmaxf(ra, s0[r]), s0[r + 1]); rb = fmaxf(fmaxf(rb, s0[r + 2]), s0[r + 3]); ra = fmaxf(fmaxf(ra, s1[r]), s1[r + 1]); rb = fmaxf(fmaxf(rb, s1[r + 2]), s1[r + 3]); }
        float rm = fmaxf(ra, rb); rm = fmaxf(rm, __shfl_xor(rm, 32));
        if (t == 0 || __any(rm > 8.f)) {
            const float dl = t == 0 ? rm : fmaxf(rm, 0.f); mref += dl; const float f = ex2(fminf(-dl, 64.f)); lsum *= f; o0 *= f; o1 *= f; s0 -= dl; s1 -= dl;
#pragma unroll
            for (int r = 0; r < 16; ++r) negm[r] = -mref;
        }
        f32x16 n0 = negm, n1 = negm;
        { const uchar* kb = Kt + (buf ^ 1) * KT_BYTES + l32 * KROW + hi * 16;
#pragma unroll
          for (int s = 0; s < 6; ++s) { const bf16x8 a0 = *(const bf16x8*)(kb + s * 32), a1 = *(const bf16x8*)(kb + 32 * KROW + s * 32); n0 = MFMA32(a0, qf[s], n0); n1 = MFMA32(a1, qf[s], n1); } }
        float ps = 0.f;
#pragma unroll
        for (int r = 0; r < 16; ++r) { s0[r] = ex2(s0[r]); s1[r] = ex2(s1[r]); ps += s0[r] + s1[r]; }
        lsum += ps;
        const uchar* vb = Vt + buf * VT_BYTES + l32 * VROW + hi * 16;
#pragma unroll
        for (int kk = 0; kk < 4; ++kk) {
            const int r0 = 8 * (kk & 1);
            const bf16x8 pf = (kk >> 1) ? pack8(s1[r0], s1[r0 + 1], s1[r0 + 2], s1[r0 + 3], s1[r0 + 4], s1[r0 + 5], s1[r0 + 6], s1[r0 + 7])
                                        : pack8(s0[r0], s0[r0 + 1], s0[r0 + 2], s0[r0 + 3], s0[r0 + 4], s0[r0 + 5], s0[r0 + 6], s0[r0 + 7]);
            const bf16x8 a0 = *(const bf16x8*)(vb + kk * 32), a1 = *(const bf16x8*)(vb + 32 * VROW + kk * 32);
            o0 = MFMA32(a0, pf, o0); o1 = MFMA32(a1, pf, o1);
        }
        if (t + 2 < nt) STOREK(buf);
        if (t + 1 < nt) STOREV(buf ^ 1);
        __syncthreads();
        s0 = n0; s1 = n1;
    }
#undef TILE_ROW
#undef LOADK
#undef LOADV
#undef STOREK
#undef STOREV
    lsum += __shfl_xor(lsum, 32); const float inv = 1.f / lsum;
#pragma unroll
    for (int rq = 0; rq < 4; ++rq) {
        u32x2 w; w.x = pk2(o0[4 * rq] * inv, o0[4 * rq + 1] * inv); w.y = pk2(o0[4 * rq + 2] * inv, o0[4 * rq + 3] * inv);
        *(u32x2*)(orow + 8 * rq + 4 * hi) = w;
        w.x = pk2(o1[4 * rq] * inv, o1[4 * rq + 1] * inv); w.y = pk2(o1[4 * rq + 2] * inv, o1[4 * rq + 3] * inv);
        *(u32x2*)(orow + 32 + 8 * rq + 4 * hi) = w;
    }
}

__device__ __forceinline__ void attn_unit2(const bf16_t* Qm, const bf16_t* KVm, const bf16_t* P1, bf16_t* OP, int q0, int h, int klat, int nlat, int kctx, int nt, uchar* lds, bool nostore = false) {
    const int tid = otid(), lane = tid & 63, wave = tid >> 6, l32 = lane & 31, hi = lane >> 5;
    uchar* Kt = lds; uchar* Vt = lds + 2 * KT_BYTES;
    const bf16_t* qrowA = Qm + (size_t)(q0 + wave * 64 + l32) * QMW + h * 96; const bf16_t* qrowB = qrowA + (size_t)32 * QMW;
    bf16_t* orowA = OP + (size_t)(q0 + wave * 64 + l32) * P1W + 2048 + h * 64; bf16_t* orowB = orowA + (size_t)32 * P1W;
    bf16x8 qa[6], qb[6];
#pragma unroll
    for (int s = 0; s < 6; ++s) { qa[s] = *(const bf16x8*)(qrowA + 16 * s + 8 * hi); qb[s] = *(const bf16x8*)(qrowB + 16 * s + 8 * hi); }
    const int kr0 = tid / 12, kc0 = tid % 12, kr1 = (512 + tid) / 12, kc1 = (512 + tid) % 12;
    const int tv = tid - 256, va = tv >> 3, vc8 = tv & 7;
    u32x4 xk0, xa = (u32x4){0u, 0u, 0u, 0u}, xb = xa;
#define TILE_ROW(j) ((j) < nlat ? klat + 64 * (j) : kctx + 64 * ((j) - nlat))
#define LOADKV(j) do { const int kb_ = TILE_ROW(j); \
        xk0 = kc0 < 8 ? *(const u32x4*)(KVm + (size_t)(kb_ + kr0) * KVW + h * 64 + 8 * kc0) : *(const u32x4*)(P1 + (size_t)(kb_ + kr0) * P1W + 2688 + 8 * (kc0 - 8)); \
        if (tid < 256) { xa = kc1 < 8 ? *(const u32x4*)(KVm + (size_t)(kb_ + kr1) * KVW + h * 64 + 8 * kc1) : *(const u32x4*)(P1 + (size_t)(kb_ + kr1) * P1W + 2688 + 8 * (kc1 - 8)); } \
        else { xa = *(const u32x4*)(KVm + (size_t)(kb_ + 2 * va) * KVW + 512 + h * 64 + 8 * vc8); xb = *(const u32x4*)(KVm + (size_t)(kb_ + 2 * va + 1) * KVW + 512 + h * 64 + 8 * vc8); } } while (0)
#define STOREKV(buf) do { *(u32x4*)(Kt + (buf) * KT_BYTES + kr0 * KROW + kc0 * 16) = xk0; \
        if (tid < 256) { *(u32x4*)(Kt + (buf) * KT_BYTES + kr1 * KROW + kc1 * 16) = xa; } \
        else { tstore_pair(Vt + (buf) * VT_BYTES, VROW, pos64(2 * va), vc8, xa, xb); } } while (0)
    LOADKV(0); STOREKV(0);
    __syncthreads();
    float mA = -1e30f, mB = -1e30f, lA = 0.f, lB = 0.f; f32x16 oA0 = {}, oA1 = {}, oB0 = {}, oB1 = {};
    for (int t = 0; t < nt; ++t) {
        const int buf = t & 1;
        if (t + 1 < nt) LOADKV(t + 1);
        f32x16 sA0 = {}, sA1 = {}, sB0 = {}, sB1 = {};
        { const uchar* kb = Kt + buf * KT_BYTES + l32 * KROW + hi * 16;
#pragma unroll
          for (int s = 0; s < 6; ++s) { const bf16x8 a0 = *(const bf16x8*)(kb + s * 32), a1 = *(const bf16x8*)(kb + 32 * KROW + s * 32);
              sA0 = MFMA32(a0, qa[s], sA0); sA1 = MFMA32(a1, qa[s], sA1); sB0 = MFMA32(a0, qb[s], sB0); sB1 = MFMA32(a1, qb[s], sB1); } }
#define SOFTMAX_BLK(S0, S1, M, L, O0, O1) do { \
        float ra = fmaxf(fmaxf(S0[0], S0[1]), S1[0]), rb = fmaxf(fmaxf(S0[2], S0[3]), S1[1]); ra = fmaxf(fmaxf(ra, S1[2]), S1[3]); \
        _Pragma("unroll") for (int r = 4; r < 16; r += 4) { ra = fmaxf(fmaxf(ra, S0[r]), S0[r + 1]); rb = fmaxf(fmaxf(rb, S0[r + 2]), S0[r + 3]); ra = fmaxf(fmaxf(ra, S1[r]), S1[r + 1]); rb = fmaxf(fmaxf(rb, S1[r + 2]), S1[r + 3]); } \
        float rm = fmaxf(ra, rb); rm = fmaxf(rm, __shfl_xor(rm, 32)); \
        if (__any(rm > M + 8.f)) { const float mn = fmaxf(M, rm), f = ex2(M - mn); M = mn; L *= f; O0 *= f; O1 *= f; } \
        float ps = 0.f; \
        _Pragma("unroll") for (int r = 0; r < 16; ++r) { S0[r] = ex2(S0[r] - M); S1[r] = ex2(S1[r] - M); ps += S0[r] + S1[r]; } \
        L += ps; } while (0)
        SOFTMAX_BLK(sA0, sA1, mA, lA, oA0, oA1);
        SOFTMAX_BLK(sB0, sB1, mB, lB, oB0, oB1);
        const uchar* vb = Vt + buf * VT_BYTES + l32 * VROW + hi * 16;
#pragma unroll
        for (int kk = 0; kk < 4; ++kk) {
            const int r0 = 8 * (kk & 1);
            const bf16x8 pa = (kk >> 1) ? pack8(sA1[r0], sA1[r0 + 1], sA1[r0 + 2], sA1[r0 + 3], sA1[r0 + 4], sA1[r0 + 5], sA1[r0 + 6], sA1[r0 + 7])
                                        : pack8(sA0[r0], sA0[r0 + 1], sA0[r0 + 2], sA0[r0 + 3], sA0[r0 + 4], sA0[r0 + 5], sA0[r0 + 6], sA0[r0 + 7]);
            const bf16x8 pb = (kk >> 1) ? pack8(sB1[r0], sB1[r0 + 1], sB1[r0 + 2], sB1[r0 + 3], sB1[r0 + 4], sB1[r0 + 5], sB1[r0 + 6], sB1[r0 + 7])
                                        : pack8(sB0[r0], sB0[r0 + 1], sB0[r0 + 2], sB0[r0 + 3], sB0[r0 + 4], sB0[r0 + 5], sB0[r0 + 6], sB0[r0 + 7]);
            const bf16x8 a0 = *(const bf16x8*)(vb + kk * 32), a1 = *(const bf16x8*)(vb + 32 * VROW + kk * 32);
            oA0 = MFMA32(a0, pa, oA0); oA1 = MFMA32(a1, pa, oA1); oB0 = MFMA32(a0, pb, oB0); oB1 = MFMA32(a1, pb, oB1);
        }
        if (t + 1 < nt) STOREKV(buf ^ 1);
        __syncthreads();
    }
#undef SOFTMAX_BLK
#undef TILE_ROW
#undef LOADKV
#undef STOREKV
    lA += __shfl_xor(lA, 32); lB += __shfl_xor(lB, 32); const float iA = 1.f / lA, iB = 1.f / lB;
    if (nostore && iA != 123.456f) return;
#pragma unroll
    for (int rq = 0; rq < 4; ++rq) {
        u32x2 w; w.x = pk2(oA0[4 * rq] * iA, oA0[4 * rq + 1] * iA); w.y = pk2(oA0[4 * rq + 2] * iA, oA0[4 * rq + 3] * iA); *(u32x2*)(orowA + 8 * rq + 4 * hi) = w;
        w.x = pk2(oA1[4 * rq] * iA, oA1[4 * rq + 1] * iA); w.y = pk2(oA1[4 * rq + 2] * iA, oA1[4 * rq + 3] * iA); *(u32x2*)(orowA + 32 + 8 * rq + 4 * hi) = w;
        w.x = pk2(oB0[4 * rq] * iB, oB0[4 * rq + 1] * iB); w.y = pk2(oB0[4 * rq + 2] * iB, oB0[4 * rq + 3] * iB); *(u32x2*)(orowB + 8 * rq + 4 * hi) = w;
        w.x = pk2(oB1[4 * rq] * iB, oB1[4 * rq + 1] * iB); w.y = pk2(oB1[4 * rq + 2] * iB, oB1[4 * rq + 3] * iB); *(u32x2*)(orowB + 32 + 8 * rq + 4 * hi) = w;
    }
}
__device__ __forceinline__ void phase_attn(const bf16_t* Qm, const bf16_t* KVm, bf16_t* P1, uchar* lds, bool with_ctx, bool nostore = false) {
    const int c = blockIdx.x, G = gridDim.x;
#ifdef ATT_R64
    for (int uidx = c; uidx < 512; uidx += G) {
        int bh, qb;
        if (G == 256) { bh = 16 * (uidx >> 8) + (c & 7) + 8 * (c >> 7); qb = (c >> 3) & 15; } else { bh = uidx >> 4; qb = uidx & 15; }
        const int b = bh >> 3, h = bh & 7;
        attn_unit2(Qm, KVm, P1, P1, b * SEQ + qb * 512, h, b * SEQ, 128, TL + b * LCTX, 132, lds, nostore);
    }
#else
    for (int uidx = c; uidx < 1024; uidx += G) {
        int bh, qb;
        if (G == 256) { bh = 8 * (uidx >> 8) + (c & 7); qb = c >> 3; } else { bh = uidx >> 5; qb = uidx & 31; }
        const int b = bh >> 3, h = bh & 7;
        attn_unit(Qm, KVm, P1, P1, b * SEQ + qb * 256, h, b * SEQ, 128, TL + b * LCTX, 132, lds);
    }
#endif
    if (with_ctx && !nostore) for (int uidx = (G >= 64 ? c - 32 : c); uidx >= 0 && uidx < 32; uidx += G) { const int b = uidx >> 3, h = uidx & 7; attn_unit(Qm, KVm, P1, P1, TL + b * LCTX, h, 0, 0, TL + b * LCTX, 4, lds); }
}

#define LAS __attribute__((address_space(3)))
#define XB_TMO      128
#define XB_XCNT(j)  (256  + 64 * (j))
#define XB_XSUB(j)  (1280 + 64 * (j))
#define XB_XGEN(j)  (2304 + 64 * (j))
#define XB_TOP      3328
#define XB_TOPGEN   3392
#define XCD_BAR_WORDS 3456
#define XB_SPIN_CAP (1u << 18)

__device__ __forceinline__ unsigned xb_ld(unsigned* p)              { return __hip_atomic_load(p, __ATOMIC_RELAXED, __HIP_MEMORY_SCOPE_AGENT); }
__device__ __forceinline__ unsigned xb_add(unsigned* p, unsigned v) { return __hip_atomic_fetch_add(p, v, __ATOMIC_RELAXED, __HIP_MEMORY_SCOPE_AGENT); }
__device__ __forceinline__ unsigned xb_xcc_id() { return (unsigned)__builtin_amdgcn_s_getreg((3 << 11) | 20) & 0xFu; }
#define XB_SPIN(cond, bar) do { unsigned _sp = 0; while (cond) { __builtin_amdgcn_s_sleep(1); \
    if ((++_sp & 255u) == 0u) { if (xb_ld(&(bar)[XB_TMO])) break; if (_sp > XB_SPIN_CAP) { atomicAdd(&(bar)[XB_TMO], 1u); break; } } } } while (0)

struct XcdBarrier {
    unsigned* bar; unsigned x;
    volatile LAS unsigned* st;
};

__device__ __forceinline__ XcdBarrier xcd_barrier_post(unsigned* bar, volatile LAS unsigned* st) {
    XcdBarrier b; b.bar = bar; b.x = xb_xcc_id(); b.st = st;
    if (threadIdx.x == 0) (void)xb_add(&bar[XB_XCNT(b.x)], 1u);
    return b;
}
__device__ __forceinline__ void xcd_barrier_complete(unsigned* bar, unsigned x, unsigned& nloc, unsigned& nx) {
    const unsigned G = gridDim.x * gridDim.y * gridDim.z;
    unsigned sum, cnt, mine, sp = 0u;
    for (;;) {
        sum = 0u; cnt = 0u; mine = 0u;
#pragma unroll
        for (unsigned j = 0; j < 16; ++j) { const unsigned c = xb_ld(&bar[XB_XCNT(j)]); sum += c; cnt += (c > 0u) ? 1u : 0u; mine = (j == x) ? c : mine; }
        if (sum == G) break;
        __builtin_amdgcn_s_sleep(1);
        if ((++sp & 255u) == 0u) { if (xb_ld(&bar[XB_TMO])) break; if (sp > XB_SPIN_CAP) { atomicAdd(&bar[XB_TMO], 1u); break; } }
    }
    nloc = mine > 0u ? mine : 1u; nx = cnt > 0u ? cnt : 1u;
}

__device__ __forceinline__ void xcd_barrier(const XcdBarrier& b) {
    asm volatile("s_waitcnt vmcnt(0)" ::: "memory");
    __syncthreads();
    if (threadIdx.x == 0) {
        unsigned* bar = b.bar;
        __builtin_amdgcn_s_waitcnt(0);
        unsigned nloc = b.st[0], nx = b.st[1];
        if (nloc == 0u) { xcd_barrier_complete(bar, b.x, nloc, nx); b.st[0] = nloc; b.st[1] = nx; }
        const unsigned old = xb_add(&bar[XB_XSUB(b.x)], 1u);
        const unsigned gen = old / nloc;
        if (old + 1u == (gen + 1u) * nloc) {
            __builtin_amdgcn_fence(__ATOMIC_RELEASE, "agent");
            asm volatile("s_waitcnt vmcnt(0)" ::: "memory");
            const unsigned og = xb_add(&bar[XB_TOP], 1u);
            const unsigned tg = og / nx;
            if (og + 1u == (tg + 1u) * nx) xb_add(&bar[XB_TOPGEN], 1u);
            else XB_SPIN(xb_ld(&bar[XB_TOPGEN]) == tg, bar);
            __builtin_amdgcn_fence(__ATOMIC_ACQUIRE, "agent");
            xb_add(&bar[XB_XGEN(b.x)], 1u);
            asm volatile("s_waitcnt vmcnt(0)" ::: "memory");
        } else {
            XB_SPIN(xb_ld(&bar[XB_XGEN(b.x)]) == gen, bar);
            __builtin_amdgcn_fence(__ATOMIC_ACQUIRE, "agent");
            asm volatile("s_waitcnt vmcnt(0)" ::: "memory");
        }
    }
    __syncthreads();
}

constexpr int NPHASE = 30;
template <class Epi> __device__ __forceinline__ void run_gemm(uchar* lds, const bf16_t* A, int lda, const bf16_t* Bt, int N, int K, const Epi& E, int M = MR) {
    pg8::Gemm g{A, Bt, M, N, K, lda}; pg8::StaticOrder S; S.init(M, N, (int)gridDim.x, (int)blockIdx.x);
    pg8::gemm_phase<Epi, pg8::StaticOrder, PG8_ALIGN_EPI, PG8_SP2_K>((PG8_LAS unsigned char*)lds, g, S, E);
}
__global__ void __launch_bounds__(512, 2) mk_fwd(KArgs a) {
    extern __shared__ __attribute__((aligned(16))) unsigned char lds[];
    cg::grid_group grid = cg::this_grid();
    unsigned char* ws = a.ws;
    float* XC = (float*)(ws + WS_XC); const float* MOD = (const float*)(ws + WS_MOD); const float* RT = (const float*)(ws + WS_ROPE);
    bf16_t* WB = (bf16_t*)(ws + WS_W); bf16_t* XN = (bf16_t*)(ws + WS_XN); bf16_t* PA = (bf16_t*)(ws + WS_A);
    bf16_t* ST = (bf16_t*)(ws + WS_ST); bf16_t* CT = (bf16_t*)(ws + WS_CT); bf16_t* QM = (bf16_t*)(ws + WS_QM); bf16_t* KVM = (bf16_t*)(ws + WS_KVM);
    float* XL = a.out;
    const int lo = a.ph_lo, hi = a.ph_hi;
    volatile LAS unsigned* ldsctl = (volatile LAS unsigned*)((LAS unsigned char*)lds + 139264);
    if (threadIdx.x < 2) ldsctl[threadIdx.x] = 0u;
    __syncthreads();
    XcdBarrier bar; bar.bar = (unsigned*)(ws + WS_CTL); bar.x = 0; bar.st = ldsctl;
    if (hi - lo > 1) bar = xcd_barrier_post((unsigned*)(ws + WS_CTL), ldsctl);
#ifdef PH_ONLY
#define PH_ON(rel) ((rel) == PH_ONLY)
#else
#define PH_ON(rel) true
#endif
#ifndef SKIP_SCAN
#define SKIP_SCAN 0
#endif
#ifndef SKIP_R3
#define SKIP_R3 0
#endif
#ifndef MIX_VARIANT
#define MIX_VARIANT 0
#endif
#ifndef PH_LIMIT
#define PH_LIMIT 100
#endif
#define PH_BEGIN(k) if (lo <= (k) && (k) < hi && ((k) < PH_LIMIT || (k) == 29) && PH_ON((k) == 0 ? 0 : ((k) == 29 ? 15 : (k) - pb + 1))) {
#ifndef PH_SUB
#define PH_SUB 255
#endif
#define SUB(n) ((PH_SUB >> (n)) & 1)
#ifdef PROBE_BAR2
#define PH_END(k) if ((k) + 1 < hi) { if ((k) == 0) grid.sync(); else { xcd_barrier(bar); xcd_barrier(bar); } } }
#else
#define PH_END(k) if ((k) + 1 < hi) { if ((k) == 0) grid.sync(); else xcd_barrier(bar); } }
#endif
    { const int pb = 1; PH_BEGIN(0) phase_mods(a, lds); __syncthreads(); phase_conv(a, lds, 0); PH_END(0) }
    for (int l = 0; l < 2; ++l) {
        const int pb = 1 + 14 * l;
        const float* mod = MOD + (size_t)l * 5 * NMOD;
        const float* xl_in = l == 0 ? a.in[0] : XL; const float* xc_in = l == 0 ? a.in[2] : XC;
        const float* dfw = a.in[13] + l * 8; const float* dbw = a.in[14] + l * 8;
        const int ML = l == 1 ? TL : MR;
        PH_BEGIN(pb + 0) if (l > 0) phase_conv(a, lds, l); phase_norm(xl_in, xc_in, mod, 0, XN); PH_END(pb + 0)
        PH_BEGIN(pb + 1) run_gemm(lds, XN, DM, WB + WE_UP1, 5632, DM, EpiUp{PA});
#ifdef PROBE_UP2X
            run_gemm(lds, XN, DM, WB + WE_UP1, 5632, DM, EpiUp{PA});
#endif
        PH_END(pb + 1)
        PH_BEGIN(pb + 2) run_gemm(lds, PA, DFF, WB + WE_DN1, DM, DFF, EpiRes{xl_in, xc_in, XL, XC, mod + 2048, 0.5f}, TL);
            ctx_gemm(PA + (size_t)TL * DFF, DFF, WB + WE_DN1, DFF, FinRes{xc_in, XC, mod + 4 * NMOD + 2048, 0.5f}, lds); PH_END(pb + 2)
        PH_BEGIN(pb + 3) phase_norm(XL, XC, mod, 3072, XN); PH_END(pb + 3)
        PH_BEGIN(pb + 4) run_gemm(lds, XN, DM, WB + WE_IN, P1W, DM, EpiRope<false>{PA, RT, RT + 2048, RT + 4096, RT + 5120}); PH_END(pb + 4)
        PH_BEGIN(pb + 5) phase_r1(PA, ST, CT, dfw, dbw, lds);
#ifdef PROBE_RET
            phase_r1(PA, ST, CT, dfw, dbw, lds);
#endif
 phase_mla_prep(PA, a.in[16] + l * 384, a.in[17] + l * 256); PH_END(pb + 5)
        PH_BEGIN(pb + 6)
#ifdef PROBE_RET
            phase_scan(ST, CT, dfw, dbw, a.ph_hi > 0);
#endif
            if (SUB(0) && !SKIP_SCAN) phase_scan(ST, CT, dfw, dbw, a.ph_hi < 0);
            if (SUB(1)) run_gemm(lds, PA + 2048, P1W, WB + WE_UQ, QMW, 384, EpiRope<true>{QM, RT, RT + 2048, RT + 4096, RT + 5120}, ML);
            run_gemm(lds, PA + 2432, P1W, WB + WE_UKV, KVW, 256, EpiBf<0>{KVM, KVW, nullptr, 0}, TL);
            ctx_gemm(PA + (size_t)TL * P1W + 2432, P1W, WB + WE_UKV, 256, FinBf<0>{KVM + (size_t)TL * KVW, KVW, nullptr, 0}, lds); PH_END(pb + 6)
        PH_BEGIN(pb + 7)
#ifdef PROBE_ATT
            phase_attn(QM, KVM, PA, lds, l == 0, a.ph_hi > 0); __syncthreads();
#endif
            if (SUB(0)) phase_attn(QM, KVM, PA, lds, l == 0, a.ph_hi < 0); __syncthreads();
#ifdef PROBE_RET
            phase_r3(PA, ST, CT, dfw, dbw, a.in[15] + l * 1024, lds, l == 0, a.ph_hi > 0);
#endif
            if (SUB(1) && !SKIP_R3) phase_r3(PA, ST, CT, dfw, dbw, a.in[15] + l * 1024, lds, l == 0, a.ph_hi < 0); PH_END(pb + 7)
        bf16_t* PAc = PA + (size_t)TL * P1W; const bf16_t* XNc = XN + (size_t)TL * DM; bf16_t* KVMc = KVM + (size_t)TL * KVW;
        PH_BEGIN(pb + 8) run_gemm(lds, XN, DM, WB + WE_G, DM, DM, EpiBf<1>{PA + 1024, P1W, nullptr, 0}, TL);
            if (l == 0) ctx_gemm(XNc, DM, WB + WE_G, DM, FinBf<1>{PAc + 1024, P1W, nullptr, 0}, lds); PH_END(pb + 8)
        PH_BEGIN(pb + 9)
            run_gemm(lds, PA + 1024, P1W, WB + WE_RO, DM, DM, EpiBf<0>{PA, P1W, nullptr, 0}, TL);
            run_gemm(lds, XN, DM, WB + WE_GR, DM, DM, EpiBf<2>{PA, P1W, nullptr, 0}, TL);
            run_gemm(lds, PA + 2048, P1W, WB + WE_MO, DM, 512, EpiBf<0>{KVM, KVW, nullptr, 0}, TL);
            run_gemm(lds, XN, DM, WB + WE_GM, DM, DM, EpiBf<3>{PA, P1W, KVM, KVW}, TL);
            if (l == 0) {
                ctx_gemm(PAc + 1024, P1W, WB + WE_RO, DM, FinBf<0>{PAc, P1W, nullptr, 0}, lds);
                ctx_gemm(XNc, DM, WB + WE_GR, DM, FinBf<2>{PAc, P1W, nullptr, 0}, lds);
                ctx_gemm(PAc + 2048, P1W, WB + WE_MO, 512, FinBf<0>{KVMc, KVW, nullptr, 0}, lds);
                ctx_gemm(XNc, DM, WB + WE_GM, DM, FinBf<3>{PAc, P1W, KVMc, KVW}, lds);
            }
        PH_END(pb + 9)
        PH_BEGIN(pb + 10) run_gemm(lds, PA, P1W, WB + WE_WO, DM, DM, EpiRes{XL, XC, XL, XC, mod + 5120, 1.0f}, TL);
            if (l == 0) ctx_gemm(PA + (size_t)TL * P1W, P1W, WB + WE_WO, DM, FinRes{XC, XC, mod + 4 * NMOD + 5120, 1.0f}, lds); PH_END(pb + 10)
        PH_BEGIN(pb + 11) phase_norm(XL, XC, mod, 6144, XN, ML); PH_END(pb + 11)
        PH_BEGIN(pb + 12) run_gemm(lds, XN, DM, WB + WE_UP2, 5632, DM, EpiUp{PA}, ML); PH_END(pb + 12)
        PH_BEGIN(pb + 13) run_gemm(lds, PA, DFF, WB + WE_DN2, DM, DFF, EpiRes{XL, XC, XL, XC, mod + 8192, 0.5f}, TL);
            if (l == 0) ctx_gemm(PA + (size_t)TL * DFF, DFF, WB + WE_DN2, DFF, FinRes{XC, XC, mod + 4 * NMOD + 8192, 0.5f}, lds); PH_END(pb + 13)
    }
    { const int pb = 1; PH_BEGIN(29) phase_final_norm(XL, a.in[23]); PH_END(29) }
#undef PH_BEGIN
#undef PH_END
}

#ifndef MK_N_LAUNCHES
#define MK_N_LAUNCHES 30
#endif
extern "C" void kernel_launch(void* const* d_in, const int* in_sizes, int n_in, void* d_out, int out_size, void* d_ws, size_t ws_size, hipStream_t stream) {
    static int grid = 0;
    if (grid == 0) {
        if (n_in != 24 || out_size != TL * DM || ws_size < WS_END) { fprintf(stderr, "kernel_launch: unexpected shapes (n_in %d out %d ws %zu)\n", n_in, out_size, ws_size); grid = -1; return; }
        int dev = 0, cus = 0, per_cu = 0;
        hipGetDevice(&dev); hipDeviceGetAttribute(&cus, hipDeviceAttributeMultiprocessorCount, dev);
        if (hipFuncSetAttribute((const void*)mk_fwd, hipFuncAttributeMaxDynamicSharedMemorySize, LDS_BYTES) != hipSuccess) { fprintf(stderr, "kernel_launch: hipFuncSetAttribute failed\n"); grid = -1; return; }
        if (hipOccupancyMaxActiveBlocksPerMultiprocessor(&per_cu, (const void*)mk_fwd, 512, LDS_BYTES) != hipSuccess || per_cu < 1) { fprintf(stderr, "kernel_launch: occupancy query says %d\n", per_cu); per_cu = 1; }
        (void)hipGetLastError();
        grid = cus * 1;
    }
    if (grid < 0) return;
    if (hipMemsetAsync((char*)d_ws + WS_CTL, 0, 16384, stream) != hipSuccess) { fprintf(stderr, "kernel_launch: hipMemsetAsync failed\n"); return; }
    KArgs a{};
    for (int i = 0; i < 24; ++i) a.in[i] = (const float*)d_in[i];
    a.out = (float*)d_out; a.ws = (unsigned char*)d_ws;
    if (MK_N_LAUNCHES == 1) {
        a.ph_lo = 0; a.ph_hi = NPHASE;
        void* args[] = {&a};
        hipError_t e = hipLaunchCooperativeKernel((const void*)mk_fwd, dim3(grid), dim3(512), args, LDS_BYTES, stream);
        if (e != hipSuccess) fprintf(stderr, "cooperative launch failed: %s (grid %d)\n", hipGetErrorString(e), grid);
    } else {
        for (int p = 0; p < NPHASE; ++p) { a.ph_lo = p; a.ph_hi = p + 1; hipLaunchKernelGGL(mk_fwd, dim3(grid), dim3(512), LDS_BYTES, stream, a); }
    }
}
```

```cpp
#define MK_N_LAUNCHES 1
#define ATT_R64 1
#define PG8_ALIGN_EPI true
#define PG8_SP2_K true
#include <hip/hip_runtime.h>
#include <hip/hip_cooperative_groups.h>
#include <cstdio>
#include <cstdint>
#include <cmath>
namespace cg = cooperative_groups;
namespace pg8 {
#define PG8_LAS __attribute__((address_space(3)))
typedef unsigned short bf16_t;
typedef short bf16x8 __attribute__((ext_vector_type(8)));
typedef float f32x4 __attribute__((ext_vector_type(4)));
typedef unsigned u32x4 __attribute__((ext_vector_type(4)));
constexpr int BM = 256, BK = 64, HALF = 128, HTB = HALF * BK * 2  , STAGE_BYTES = 8 * HTB, NXCD = 8, WGM = 4;

__host__ __device__ __forceinline__ int lds_byte(int r, int c) { const int st = (r >> 4) * 2 + (c >> 5), rr = r & 15, cc = c & 31, ob = rr * 64 + cc * 2; return st * 1024 + (ob ^ (((ob >> 9) & 1) << 5)); }
__host__ __device__ __forceinline__ void stage_rc(int b, int& R, int& C) { const int st = b / 1024, sb = b % 1024, swz = sb ^ (((sb >> 9) & 1) << 5); R = (st >> 1) * 16 + swz / 64; C = (st & 1) * 32 + (swz % 64) / 2; }
__host__ __device__ __forceinline__ int perm32(int rho) { const int n = rho >> 4, i = rho & 15; return 8 * (i >> 2) + 4 * n + (i & 3); }

struct Unit { int pm, pn; };
struct Gemm { const bf16_t* A; const bf16_t* Bt; int M, N, K, lda; };

struct StaticOrder {
    int nM, nN, nwg, G, c;
    __host__ __device__ void init(int M, int N, int G_, int c_) { nM = M / BM; nN = N / BM; nwg = nM * nN; G = G_; c = c_; }
    __host__ __device__ bool next(int i, Unit& u) const {
        const long L = (long)i * G + c; if (L >= nwg) return false;
        int wgid = (int)L; { const int q = nwg / NXCD, r = nwg % NXCD, xcd = wgid % NXCD, off = wgid / NXCD; wgid = (xcd < r ? xcd * (q + 1) : r * (q + 1) + (xcd - r) * q) + off; }
        const int nig = WGM * nN, gid = wgid / nig, fm = gid * WGM, gsz = (nM - fm) < WGM ? (nM - fm) : WGM;
        u.pm = fm + ((wgid % nig) % gsz); u.pn = (wgid % nig) / gsz; return true;
    }
    __device__ __forceinline__ void a_ready(const Unit&) const {}
    __device__ __forceinline__ void done(const Unit&) const {}
};

__device__ __forceinline__ unsigned cvt_pk_bf16(float lo, float hi) { unsigned r; asm volatile("v_cvt_pk_bf16_f32 %0, %1, %2" : "=v"(r) : "v"(lo), "v"(hi)); return r; }
typedef float f32x2 __attribute__((ext_vector_type(2)));
template <class Epi, class Sched, bool ALIGN_EPI = false, bool SP2 = false>
__device__ __forceinline__ void gemm_phase(PG8_LAS unsigned char* lds, const Gemm g, const Sched& S, const Epi& E) {
    int tid_ = threadIdx.x; asm volatile("" : "+v"(tid_)); const int tid = tid_, wid = __builtin_amdgcn_readfirstlane(tid >> 6), lane = tid & 63, wr = wid >> 2, wc = wid & 3, fr = lane & 15, fq = lane >> 4;
    const int K = g.K, nt = K / BK;
    unsigned voffA[2], voffB[2];
#pragma unroll
    for (int i = 0; i < 2; ++i) { int R, C; stage_rc(tid * 16 + i * 8192, R, C); const int Rb = Epi::PERM ? ((R & ~31) + perm32(R & 31)) : R;
        voffA[i] = (unsigned)(R * g.lda + C) * 2u; voffB[i] = (unsigned)(Rb * K + C) * 2u; }
    const size_t kstep = (size_t)(BK * 2);
    const size_t hstepA = (size_t)HALF * g.lda * 2, hstepB = (size_t)HALF * K * 2;
    const size_t tstepA = 2 * hstepA, tstepB = 2 * hstepB;
    const unsigned ldsw = (unsigned)wid * 1024u;
    const int aoff = lds_byte(wr * 64 + fr, fq * 8), boff = lds_byte(wc * 32 + fr, fq * 8);
#define PG8_SA(b, h) (((b) * 2 + (h)) * HTB)
#define PG8_SB(b, h) ((4 + (b) * 2 + (h)) * HTB)
#define PG8_STAGE(bufoff, gbase, voff) do { _Pragma("unroll") for (int _i = 0; _i < 2; ++_i) \
        __builtin_amdgcn_global_load_lds((const unsigned*)((const char*)(gbase) + (voff)[_i]), (PG8_LAS unsigned*)(lds + (bufoff) + ldsw + _i * 8192), 16, 0, 0); } while (0)
#define PG8_LDA(dst, b, h) do { _Pragma("unroll") for (int m = 0; m < 4; ++m) _Pragma("unroll") for (int k = 0; k < 2; ++k) dst[m][k] = *(const PG8_LAS bf16x8*)(lds + PG8_SA(b, h) + aoff + m * 2048 + k * 1024); } while (0)
#define PG8_LDB(dst, b, h) do { _Pragma("unroll") for (int n = 0; n < 2; ++n) _Pragma("unroll") for (int k = 0; k < 2; ++k) dst[n][k] = *(const PG8_LAS bf16x8*)(lds + PG8_SB(b, h) + boff + n * 2048 + k * 1024); } while (0)
#define PG8_MMA(ai, bj, At, Bt) do { __builtin_amdgcn_s_setprio(1); _Pragma("unroll") for (int m = 0; m < 4; ++m) _Pragma("unroll") for (int n = 0; n < 2; ++n) _Pragma("unroll") for (int k = 0; k < 2; ++k) \
        acc[ai][bj][m][n] = __builtin_amdgcn_mfma_f32_16x16x32_bf16(Bt[n][k], At[m][k], acc[ai][bj][m][n], 0, 0, 0); __builtin_amdgcn_s_setprio(0); } while (0)
#define PG8_WAIT_V(n) asm volatile("s_waitcnt vmcnt(" #n ")" ::: "memory")
#define PG8_WAIT_L(n) asm volatile("s_waitcnt lgkmcnt(" #n ")" ::: "memory")
#define PG8_BAR __builtin_amdgcn_s_barrier()
#define PG8_SCHED __builtin_amdgcn_sched_barrier(0)
    Unit cur, nxt; int ui = 0;
    if (!S.next(0, cur)) return;
    f32x4 acc[2][2][4][2];
#pragma unroll
    for (int a = 0; a < 2; ++a)
#pragma unroll
        for (int b = 0; b < 2; ++b)
#pragma unroll
            for (int m = 0; m < 4; ++m)
#pragma unroll
                for (int n = 0; n < 2; ++n) acc[a][b][m][n] = (f32x4){0.f, 0.f, 0.f, 0.f};
    bf16x8 At[4][2], B0[2][2], B1[2][2];
    const char* cA = (const char*)g.A + (size_t)cur.pm * tstepA; const char* cB = (const char*)g.Bt + (size_t)cur.pn * tstepB;
    S.a_ready(cur);
    if constexpr (SP2) {
        PG8_STAGE(PG8_SB(0, 0), cB, voffB); PG8_STAGE(PG8_SB(0, 1), cB + hstepB, voffB); PG8_STAGE(PG8_SA(0, 0), cA, voffA); PG8_STAGE(PG8_SA(0, 1), cA + hstepA, voffA);
        if (wr == 1) PG8_BAR;
        PG8_WAIT_V(2); PG8_BAR;
        PG8_STAGE(PG8_SB(1, 0), cB + kstep, voffB); PG8_STAGE(PG8_SA(1, 0), cA + kstep, voffA); PG8_STAGE(PG8_SB(1, 1), cB + hstepB + kstep, voffB);
        PG8_WAIT_V(6); PG8_BAR;
    } else {
        PG8_STAGE(PG8_SB(0, 0), cB, voffB); PG8_STAGE(PG8_SA(0, 0), cA, voffA); PG8_STAGE(PG8_SB(0, 1), cB + hstepB, voffB); PG8_STAGE(PG8_SA(0, 1), cA + hstepA, voffA);
        if (wr == 1) PG8_BAR;
        PG8_WAIT_V(4); PG8_BAR;
        PG8_STAGE(PG8_SB(1, 0), cB + kstep, voffB); PG8_STAGE(PG8_SA(1, 0), cA + kstep, voffA); PG8_STAGE(PG8_SB(1, 1), cB + hstepB + kstep, voffB);
        PG8_WAIT_V(6); PG8_BAR;
    }
    for (;;) {
        const bool has_next = S.next(ui + 1, nxt);
        const char* nA = has_next ? (const char*)g.A + (size_t)nxt.pm * tstepA : cA; const char* nB = has_next ? (const char*)g.Bt + (size_t)nxt.pn * tstepB : cB;
#pragma nounroll
        for (int t = 0; t < nt; t += 2) {
            const bool last = (t == nt - 2);
            const char* a1 = cA + (size_t)(t + 1) * kstep;
            const char* a2 = last ? nA : cA + (size_t)(t + 2) * kstep; const char* b2 = last ? nB : cB + (size_t)(t + 2) * kstep;
            const char* a3 = a2 + kstep; const char* b3 = b2 + kstep;
            if (last && has_next) S.a_ready(nxt);
            if constexpr (SP2) {
            PG8_LDB(B0, 0, 0); PG8_LDB(B1, 0, 1); PG8_SCHED; PG8_LDA(At, 0, 0); PG8_STAGE(PG8_SA(1, 1), a1 + hstepA, voffA);
            PG8_WAIT_V(8); PG8_WAIT_L(0); PG8_BAR; PG8_MMA(0, 0, At, B0); PG8_MMA(0, 1, At, B1); PG8_BAR; PG8_SCHED;
            PG8_LDA(At, 0, 1); PG8_STAGE(PG8_SB(0, 0), b2, voffB); PG8_STAGE(PG8_SB(0, 1), b2 + hstepB, voffB); PG8_STAGE(PG8_SA(0, 0), a2, voffA);
            PG8_WAIT_V(8); PG8_WAIT_L(0); PG8_BAR; PG8_MMA(1, 0, At, B0); PG8_MMA(1, 1, At, B1); PG8_BAR; PG8_SCHED;
            PG8_LDB(B0, 1, 0); PG8_LDB(B1, 1, 1); PG8_SCHED; PG8_LDA(At, 1, 0); PG8_STAGE(PG8_SA(0, 1), a2 + hstepA, voffA);
            PG8_WAIT_V(8); PG8_WAIT_L(0); PG8_BAR; PG8_MMA(0, 0, At, B0); PG8_MMA(0, 1, At, B1); PG8_BAR; PG8_SCHED;
            PG8_LDA(At, 1, 1); PG8_STAGE(PG8_SB(1, 0), b3, voffB); PG8_STAGE(PG8_SB(1, 1), b3 + hstepB, voffB); PG8_STAGE(PG8_SA(1, 0), a3, voffA);
            PG8_WAIT_V(8); PG8_WAIT_L(0); PG8_BAR; PG8_MMA(1, 0, At, B0); PG8_MMA(1, 1, At, B1); PG8_BAR; PG8_SCHED;
            } else {
            PG8_LDB(B0, 0, 0); PG8_SCHED; PG8_LDA(At, 0, 0); PG8_STAGE(PG8_SA(1, 1), a1 + hstepA, voffA);
            PG8_WAIT_L(8); PG8_BAR; PG8_WAIT_L(0); PG8_MMA(0, 0, At, B0); PG8_BAR; PG8_SCHED;
            PG8_LDB(B1, 0, 1); PG8_STAGE(PG8_SB(0, 0), b2, voffB);
            PG8_BAR; PG8_WAIT_L(0); PG8_MMA(0, 1, At, B1); PG8_BAR;
            PG8_LDA(At, 0, 1); PG8_STAGE(PG8_SA(0, 0), a2, voffA);
            PG8_BAR; PG8_WAIT_L(0); PG8_MMA(1, 0, At, B0); PG8_BAR; PG8_SCHED;
            PG8_STAGE(PG8_SB(0, 1), b2 + hstepB, voffB);
            PG8_WAIT_V(6); PG8_BAR; PG8_MMA(1, 1, At, B1); PG8_BAR;
            PG8_LDB(B0, 1, 0); PG8_SCHED; PG8_LDA(At, 1, 0); PG8_STAGE(PG8_SA(0, 1), a2 + hstepA, voffA);
            PG8_WAIT_L(8); PG8_BAR; PG8_WAIT_L(0); PG8_MMA(0, 0, At, B0); PG8_BAR; PG8_SCHED;
            PG8_LDB(B1, 1, 1); PG8_STAGE(PG8_SB(1, 0), b3, voffB);
            PG8_BAR; PG8_WAIT_L(0); PG8_MMA(0, 1, At, B1); PG8_BAR;
            PG8_LDA(At, 1, 1); PG8_STAGE(PG8_SA(1, 0), a3, voffA);
            PG8_BAR; PG8_WAIT_L(0); PG8_MMA(1, 0, At, B0); PG8_BAR; PG8_SCHED;
            PG8_STAGE(PG8_SB(1, 1), b3 + hstepB, voffB);
            PG8_WAIT_V(6); PG8_BAR; PG8_MMA(1, 1, At, B1); PG8_BAR;
            }
        }
        if constexpr (ALIGN_EPI) { if (wr == 0) PG8_BAR; }
        if constexpr (!Epi::AFTER_DRAIN) { E(acc, cur, wr, wc, fr, fq); S.done(cur); }
        if (!has_next) break;
#pragma unroll
        for (int a = 0; a < 2; ++a)
#pragma unroll
            for (int b = 0; b < 2; ++b)
#pragma unroll
                for (int m = 0; m < 4; ++m)
#pragma unroll
                    for (int n = 0; n < 2; ++n) acc[a][b][m][n] = (f32x4){0.f, 0.f, 0.f, 0.f};
        cur = nxt; cA = nA; cB = nB; ++ui;
        if constexpr (ALIGN_EPI) { if (wr == 1) PG8_BAR; }
    }
    PG8_WAIT_V(0);
    if constexpr (!ALIGN_EPI) { if (wr == 0) PG8_BAR; }
    PG8_BAR;
    if constexpr (Epi::AFTER_DRAIN) { E.fused(acc, cur, wr, wc, fr, fq, lds, wid, lane); S.done(cur); }
#undef PG8_SA
#undef PG8_SB
#undef PG8_STAGE
#undef PG8_LDA
#undef PG8_LDB
#undef PG8_MMA
#undef PG8_WAIT_V
#undef PG8_WAIT_L
#undef PG8_BAR
#undef PG8_SCHED
}
}

using pg8::bf16_t; using pg8::bf16x8; using pg8::f32x4; using pg8::u32x4;
typedef float f32x16 __attribute__((ext_vector_type(16)));
typedef unsigned u32x2 __attribute__((ext_vector_type(2)));
typedef unsigned char uchar;
constexpr int NB = 4, SEQ = 8192, DM = 1024, LCTX = 256, DFF = 2816;
constexpr int TL = NB * SEQ;
constexpr int TC = NB * LCTX;
constexpr int MR = TL + TC;
constexpr int NMOD = 9 * DM;
constexpr int INW = 5792;
constexpr int P1W = 2816;
constexpr int QMW = 768, KVW = 1024;
constexpr float EPSN = 1e-6f;
constexpr float LOG2E = 1.4426950408889634f;
constexpr float MLA_C2 = 0.10206207261596575f * 1.4426950408889634f;
constexpr int LDS_BYTES = 147456;

constexpr size_t WS_XC = 0;
constexpr size_t WS_MOD = 4194304;
constexpr size_t WS_ROPE = 4718592;
constexpr size_t WS_W = 5242880;
constexpr size_t WE_UP1 = 0, WE_DN1 = 5767168, WE_UP2 = 8650752, WE_DN2 = 14417920, WE_IN = 17301504, WE_G = 20185088, WE_GR = 21233664, WE_GM = 22282240,
                 WE_UQ = 23330816, WE_UKV = 23625728, WE_RO = 23887872, WE_MO = 24936448, WE_WO = 25722880, WE_END = 26771456;
constexpr size_t WS_XN = WS_W + WE_END * 2;
constexpr size_t WS_A = WS_XN + (size_t)MR * DM * 2;
constexpr size_t WS_ST = WS_A + (size_t)MR * P1W * 2;
constexpr size_t WS_CT = WS_ST + 67108864;
constexpr size_t WS_QM = WS_CT + 2097152;
constexpr size_t WS_KVM = WS_QM + (size_t)MR * QMW * 2;
constexpr size_t WS_CTL = WS_KVM + (size_t)MR * KVW * 2;
constexpr size_t WS_END = WS_CTL + 16384;
static_assert(WS_END <= 536870912 && WS_CTL % 256 == 0, "workspace map exceeds 512 MiB");

struct KArgs { const float* in[24]; float* out; unsigned char* ws; int ph_lo, ph_hi; };

__device__ __forceinline__ int otid() { int t = threadIdx.x; asm volatile("" : "+v"(t)); return t; }
typedef float f32x2_t __attribute__((ext_vector_type(2))); typedef __bf16 bf16x2_t __attribute__((ext_vector_type(2)));
__device__ __forceinline__ unsigned pk2(float lo, float hi) { f32x2_t v = {lo, hi}; bf16x2_t b = __builtin_convertvector(v, bf16x2_t); return __builtin_bit_cast(unsigned, b); }
__device__ __forceinline__ float bf_lo(unsigned w) { return __uint_as_float(w << 16); }
__device__ __forceinline__ float bf_hi(unsigned w) { return __uint_as_float(w & 0xffff0000u); }
__device__ __forceinline__ float ex2(float x) { return __builtin_amdgcn_exp2f(x); }
__device__ __forceinline__ float sigm(float a) { return __builtin_amdgcn_rcpf(1.f + __builtin_amdgcn_exp2f(-a * LOG2E)); }
__device__ __forceinline__ float silu(float a) { return a * sigm(a); }
__device__ __forceinline__ float sigm2(float a2) { return __builtin_amdgcn_rcpf(1.f + __builtin_amdgcn_exp2f(-a2)); }
__device__ __forceinline__ int crow(int r, int hi) { return (r & 3) + 8 * (r >> 2) + 4 * hi; }
__device__ __forceinline__ int pos64(int kv) { const int p = kv >> 5, w = kv & 31; return 16 * (2 * p + (w >> 4)) + 8 * ((w >> 2) & 1) + (w & 3) + 4 * ((w >> 3) & 1); }
__device__ __forceinline__ float max_xor32(float v) { const auto rr = __builtin_amdgcn_permlane32_swap(__float_as_uint(v), __float_as_uint(v), false, false); return fmaxf(__uint_as_float(rr[0]), __uint_as_float(rr[1])); }
__device__ __forceinline__ float wave_sum(float v) {
#pragma unroll
    for (int o = 1; o < 64; o <<= 1) v += __shfl_xor(v, o);
    return v;
}
__device__ __forceinline__ bf16x8 pack8(float a0, float a1, float a2, float a3, float a4, float a5, float a6, float a7) {
    u32x4 w; w.x = pk2(a0, a1); w.y = pk2(a2, a3); w.z = pk2(a4, a5); w.w = pk2(a6, a7); return __builtin_bit_cast(bf16x8, w);
}
#define MFMA32(a, b, c) __builtin_amdgcn_mfma_f32_32x32x16_bf16((a), (b), (c), 0, 0, 0)

struct EpiUp {
    static constexpr bool PERM = true, AFTER_DRAIN = false;
    bf16_t* H;
    __device__ __forceinline__ void operator()(const f32x4 (&acc)[2][2][4][2], const pg8::Unit& u, int wr, int wc, int fr, int fq) const {
        const int row0 = u.pm * 256 + wr * 64 + fr, col = u.pn * 128 + wc * 32 + 8 * fq;
#pragma unroll
        for (int ai = 0; ai < 2; ++ai)
#pragma unroll
            for (int m = 0; m < 4; ++m) {
                const f32x4 a0 = acc[ai][0][m][0], a1 = acc[ai][0][m][1], b0 = acc[ai][1][m][0], b1 = acc[ai][1][m][1];
                u32x4 w;
#define SWG(a, b) ((a) * (b) * __builtin_amdgcn_rcpf(1.f + __builtin_amdgcn_exp2f(-(a))))
                w.x = pk2(SWG(a0[0], b0[0]), SWG(a0[1], b0[1])); w.y = pk2(SWG(a0[2], b0[2]), SWG(a0[3], b0[3]));
                w.z = pk2(SWG(a1[0], b1[0]), SWG(a1[1], b1[1])); w.w = pk2(SWG(a1[2], b1[2]), SWG(a1[3], b1[3]));
#undef SWG
                *(u32x4*)(H + (size_t)(row0 + ai * 128 + m * 16) * DFF + col) = w;
            }
    }
};
struct EpiRes {
    static constexpr bool PERM = false, AFTER_DRAIN = false;
    const float* bl; const float* bc; float* ol; float* oc; const float* gate; float gs;
    __device__ __forceinline__ void operator()(const f32x4 (&acc)[2][2][4][2], const pg8::Unit& u, int wr, int wc, int fr, int fq) const {
        const bool lat = u.pm < 128; const int ms = lat ? (u.pm >> 5) : 4;
        const size_t toff = (size_t)(lat ? u.pm : u.pm - 128) * 256 * DM;
        const float* base = (lat ? bl : bc) + toff; float* out = (lat ? ol : oc) + toff;
        const float* g = gate + ms * NMOD; const int col0 = u.pn * 256 + wc * 32 + 4 * fq;
#pragma unroll
        for (int bj = 0; bj < 2; ++bj)
#pragma unroll
            for (int n = 0; n < 2; ++n) {
                const f32x4 gv = *(const f32x4*)(g + col0 + bj * 128 + n * 16) * gs;
                f32x4 b[8];
#pragma unroll
                for (int i = 0; i < 8; ++i) b[i] = *(const f32x4*)(base + (size_t)((i >> 2) * 128 + wr * 64 + (i & 3) * 16 + fr) * DM + col0 + bj * 128 + n * 16);
#pragma unroll
                for (int i = 0; i < 8; ++i) *(f32x4*)(out + (size_t)((i >> 2) * 128 + wr * 64 + (i & 3) * 16 + fr) * DM + col0 + bj * 128 + n * 16) = b[i] + gv * acc[i >> 2][bj][i & 3][n];
                asm volatile("" ::: "memory");
            }
    }
};
template <int MODE> struct EpiBf {
    static constexpr bool PERM = true, AFTER_DRAIN = false;
    bf16_t* O; int ldc; const bf16_t* X; int ldx;
    __device__ __forceinline__ void operator()(const f32x4 (&acc)[2][2][4][2], const pg8::Unit& u, int wr, int wc, int fr, int fq) const {
        const int row0 = u.pm * 256 + wr * 64 + fr, col0 = u.pn * 256 + wc * 32 + 8 * fq;
#pragma unroll
        for (int ai = 0; ai < 2; ++ai)
#pragma unroll
            for (int mh = 0; mh < 2; ++mh) {
                u32x4 cw[4], xw[4];
                if (MODE != 0) {
#pragma unroll
                    for (int i = 0; i < 4; ++i) { const size_t row = (size_t)(row0 + ai * 128 + (2 * mh + (i >> 1)) * 16); const int co = col0 + (i & 1) * 128;
                        cw[i] = *(const u32x4*)(O + row * ldc + co); if (MODE >= 3) xw[i] = *(const u32x4*)(X + row * ldx + co); }
                }
#pragma unroll
                for (int i = 0; i < 4; ++i) {
                    const int m = 2 * mh + (i >> 1), bj = i & 1;
                    bf16_t* p = O + (size_t)(row0 + ai * 128 + m * 16) * ldc + col0 + bj * 128;
                    const f32x4 v0 = acc[ai][bj][m][0], v1 = acc[ai][bj][m][1];
                    float v[8] = {v0[0], v0[1], v0[2], v0[3], v1[0], v1[1], v1[2], v1[3]};
                    if (MODE != 0) {
                        float c[8] = {bf_lo(cw[i].x), bf_hi(cw[i].x), bf_lo(cw[i].y), bf_hi(cw[i].y), bf_lo(cw[i].z), bf_hi(cw[i].z), bf_lo(cw[i].w), bf_hi(cw[i].w)};
                        if (MODE == 1) {
#pragma unroll
                            for (int e = 0; e < 8; ++e) v[e] = v[e] * sigm2(v[e]) * c[e];
                        } else if (MODE == 2) {
#pragma unroll
                            for (int e = 0; e < 8; ++e) v[e] = sigm2(v[e]) * c[e];
                        } else {
                            float x[8] = {bf_lo(xw[i].x), bf_hi(xw[i].x), bf_lo(xw[i].y), bf_hi(xw[i].y), bf_lo(xw[i].z), bf_hi(xw[i].z), bf_lo(xw[i].w), bf_hi(xw[i].w)};
#pragma unroll
                            for (int e = 0; e < 8; ++e) v[e] = (MODE == 4 ? 0.f : c[e]) + sigm2(v[e]) * x[e];
                        }
                    }
                    u32x4 w; w.x = pk2(v[0], v[1]); w.y = pk2(v[2], v[3]); w.z = pk2(v[4], v[5]); w.w = pk2(v[6], v[7]);
                    *(u32x4*)p = w;
                }
                asm volatile("" ::: "memory");
            }
    }
};
template <bool IS_UQ> struct EpiRope {
    static constexpr bool PERM = true, AFTER_DRAIN = false;
    bf16_t* O; const float* rt16c; const float* rt16s; const float* rt8c; const float* rt8s;
    __device__ __forceinline__ void operator()(const f32x4 (&acc)[2][2][4][2], const pg8::Unit& u, int wr, int wc, int fr, int fq) const {
        constexpr int LDC = IS_UQ ? QMW : P1W;
#pragma unroll
        for (int ai = 0; ai < 2; ++ai)
#pragma unroll
            for (int m = 0; m < 4; ++m) {
                const int row = u.pm * 256 + ai * 128 + wr * 64 + m * 16 + fr;
                const bool lat = row < TL; const int t = row & (SEQ - 1), pr = t >> 6, pc = t & 63;
#pragma unroll
                for (int bj = 0; bj < 2; ++bj) {
                    const int cg = (u.pn * 256 + bj * 128 + wc * 32) >> 5;
                    f32x4 v0 = acc[ai][bj][m][0], v1 = acc[ai][bj][m][1];
                    bool r16 = false, r8 = false; float sc = 1.f;
                    if (IS_UQ) { r8 = (cg % 3) == 2; sc = MLA_C2; }
                    else { r16 = cg < 32; r8 = cg == 84; if (cg >= 16 && cg < 32) sc = 0.125f; }
                    if (r16 && lat) {
                        const int pos = (cg & 1) ? pc : pr;
                        const f32x4 cs = *(const f32x4*)(rt16c + pos * 16 + 4 * fq), sn = *(const f32x4*)(rt16s + pos * 16 + 4 * fq);
                        const f32x4 o0 = v0 * cs - v1 * sn, o1 = v1 * cs + v0 * sn; v0 = o0; v1 = o1;
                    }
                    if (r8 && lat) {
                        const int pos = (fq >> 1) ? pc : pr;
                        const f32x4 cs = *(const f32x4*)(rt8c + pos * 8 + 4 * (fq & 1)), sn = *(const f32x4*)(rt8s + pos * 8 + 4 * (fq & 1));
                        const f32x4 o0 = v0 * cs - v1 * sn, o1 = v1 * cs + v0 * sn; v0 = o0; v1 = o1;
                    }
                    v0 = v0 * sc; v1 = v1 * sc;
                    u32x4 w; w.x = pk2(v0[0], v0[1]); w.y = pk2(v0[2], v0[3]); w.z = pk2(v1[0], v1[1]); w.w = pk2(v1[2], v1[3]);
                    *(u32x4*)(O + (size_t)row * LDC + cg * 32 + 8 * fq) = w;
                }
            }
    }
};


struct FinRes { const float* base; float* out; const float* gate; float gs;
    __device__ __forceinline__ void operator()(int r, int c, f32x4 s0, f32x4 s1) const {
        const size_t off = (size_t)r * DM + c;
        const f32x4 g0 = *(const f32x4*)(gate + c) * gs, g1 = *(const f32x4*)(gate + c + 4) * gs;
        const f32x4 x0 = *(const f32x4*)(base + off), x1 = *(const f32x4*)(base + off + 4);
        *(f32x4*)(out + off) = x0 + g0 * s0; *(f32x4*)(out + off + 4) = x1 + g1 * s1; } };
template <int MODE> struct FinBf { bf16_t* O; int ldc; const bf16_t* X; int ldx;
    __device__ __forceinline__ void operator()(int r, int c, f32x4 s0, f32x4 s1) const {
        bf16_t* p = O + (size_t)r * ldc + c;
        float v[8] = {s0[0], s0[1], s0[2], s0[3], s1[0], s1[1], s1[2], s1[3]};
        if (MODE != 0) {
            const u32x4 cw = *(const u32x4*)p;
            float cc[8] = {bf_lo(cw.x), bf_hi(cw.x), bf_lo(cw.y), bf_hi(cw.y), bf_lo(cw.z), bf_hi(cw.z), bf_lo(cw.w), bf_hi(cw.w)};
            if (MODE == 1) {
#pragma unroll
                for (int i = 0; i < 8; ++i) v[i] = v[i] * sigm2(v[i]) * cc[i];
            } else if (MODE == 2) {
#pragma unroll
                for (int i = 0; i < 8; ++i) v[i] = sigm2(v[i]) * cc[i];
            } else {
                const u32x4 xw = *(const u32x4*)(X + (size_t)r * ldx + c);
                float x[8] = {bf_lo(xw.x), bf_hi(xw.x), bf_lo(xw.y), bf_hi(xw.y), bf_lo(xw.z), bf_hi(xw.z), bf_lo(xw.w), bf_hi(xw.w)};
#pragma unroll
                for (int i = 0; i < 8; ++i) v[i] = cc[i] + sigm2(v[i]) * x[i];
            }
        }
        u32x4 w; w.x = pk2(v[0], v[1]); w.y = pk2(v[2], v[3]); w.z = pk2(v[4], v[5]); w.w = pk2(v[6], v[7]);
        *(u32x4*)p = w; } };
template <class Fin> __device__ __forceinline__ void ctx_gemm(const bf16_t* A, int lda, const bf16_t* Bt, int K, const Fin& fin, uchar* lds) {
    const int tid = otid(), lane = tid & 63, wave = tid >> 6, l32 = lane & 31, hi = lane >> 5;
    float* red = (float*)lds;
    const int kw = K >> 3, nst = kw >> 4;
    for (int id = blockIdx.x; id < 256; id += gridDim.x) {
        const int tr = id >> 3, tc = id & 7;
        const bf16_t* ap = A + (size_t)(tr * 32 + l32) * lda + wave * kw + 8 * hi;
        const bf16_t* bp = Bt + (size_t)(tc * 128 + l32) * K + wave * kw + 8 * hi;
        f32x16 acc0 = {}, acc1 = {}, acc2 = {}, acc3 = {};
#pragma unroll 8
        for (int s = 0; s < nst; ++s) {
            const bf16x8 af = *(const bf16x8*)(ap + 16 * s);
            const bf16x8 b0 = *(const bf16x8*)(bp + 16 * s), b1 = *(const bf16x8*)(bp + (size_t)32 * K + 16 * s), b2 = *(const bf16x8*)(bp + (size_t)64 * K + 16 * s), b3 = *(const bf16x8*)(bp + (size_t)96 * K + 16 * s);
            acc0 = MFMA32(af, b0, acc0); acc1 = MFMA32(af, b1, acc1); acc2 = MFMA32(af, b2, acc2); acc3 = MFMA32(af, b3, acc3);
        }
        float* rw = red + wave * 4096 + l32;
#pragma unroll
        for (int r = 0; r < 16; ++r) { float* q = rw + crow(r, hi) * 128; q[0] = acc0[r]; q[32] = acc1[r]; q[64] = acc2[r]; q[96] = acc3[r]; }
        __syncthreads();
        const int row = tid >> 4, c8 = (tid & 15) * 8;
        f32x4 s0 = {}, s1 = {};
#pragma unroll
        for (int w = 0; w < 8; ++w) { s0 += *(const f32x4*)(red + w * 4096 + row * 128 + c8); s1 += *(const f32x4*)(red + w * 4096 + row * 128 + c8 + 4); }
        fin(tr * 32 + row, tc * 128 + c8, s0, s1);
        __syncthreads();
    }
}
__device__ __forceinline__ void sincos_d(double x, double& s, double& c) {
    const double TWO_PI = 6.283185307179586476925;
    const double k = rint(x / TWO_PI); const double r = x - k * TWO_PI; const double r2 = r * r;
    double ss = 1.0, cc = 1.0;
#pragma unroll
    for (int n = 15; n >= 1; --n) { ss = 1.0 - r2 / (double)((2 * n) * (2 * n + 1)) * ss; cc = 1.0 - r2 / (double)((2 * n - 1) * (2 * n)) * cc; }
    s = r * ss; c = cc;
}
__device__ __forceinline__ void phase_mods(const KArgs& a, uchar* lds) {
    const int tid = otid(), lane = tid & 63, wave = tid >> 6;
    float* sm = (float*)lds; float* red = sm + 5 * 1024;
    for (int idx = tid; idx < 5 * 1024; idx += 512) { const int ms = idx >> 10, k = idx & 1023; const float c = ms < 4 ? a.in[1][ms * 1024 + k] : a.in[3][k]; sm[idx] = c / (1.f + expf(-c)); }
    __syncthreads();
    float* mod = (float*)(a.ws + WS_MOD);
    for (int item = blockIdx.x; item < 288; item += gridDim.x) {
        const int l = item / 144, j = (item % 144) * 64 + lane;
        const float* w = a.in[4] + (size_t)l * 1024 * NMOD + j;
        float acc[5] = {0.f, 0.f, 0.f, 0.f, 0.f};
#pragma unroll 32
        for (int kk = 0; kk < 128; ++kk) { const int k = wave * 128 + kk; const float wv = w[(size_t)k * NMOD];
#pragma unroll
            for (int ms = 0; ms < 5; ++ms) acc[ms] += sm[ms * 1024 + k] * wv; }
#pragma unroll
        for (int ms = 0; ms < 5; ++ms) red[(wave * 5 + ms) * 64 + lane] = acc[ms];
        __syncthreads();
        if (wave == 0) {
#pragma unroll
            for (int ms = 0; ms < 5; ++ms) { float s = 0.f;
#pragma unroll
                for (int w8 = 0; w8 < 8; ++w8) s += red[(w8 * 5 + ms) * 64 + lane];
                mod[(size_t)(l * 5 + ms) * NMOD + j] = s + a.in[5][l * NMOD + j]; }
        }
        __syncthreads();
    }
    float* rt = (float*)(a.ws + WS_ROPE);
    for (int idx = blockIdx.x * 512 + tid; idx < 128 * 24; idx += gridDim.x * 512) {
        const int pos = idx / 24, f = idx % 24;
        const float invf = f < 16 ? exp2f(-(float)f * (13.287712379549449f / 16.f)) : exp2f(-(float)(f - 16) * (13.287712379549449f / 8.f));
        const float ang = (float)pos * invf; double s, c; sincos_d((double)ang, s, c);
        if (f < 16) { rt[pos * 16 + f] = (float)c; rt[2048 + pos * 16 + f] = (float)s; }
        else { rt[4096 + pos * 8 + (f - 16)] = (float)c; rt[5120 + pos * 8 + (f - 16)] = (float)s; }
    }
}
__device__ __forceinline__ int rope16_perm(int p) { return 32 * (p >> 5) + 16 * ((p >> 2) & 1) + 4 * ((p >> 3) & 3) + (p & 3); }
__device__ __forceinline__ int rope8_perm(int p) { const int fq = p >> 3; return 16 * (fq >> 1) + 8 * ((p >> 2) & 1) + 4 * (fq & 1) + (p & 3); }
template <int MODE> __device__ __forceinline__ void conv_item(const float* W, const float* W2, int Nsrc, int N, int Kd, int coff, bf16_t* WT, float* scr, int item, int lane, float wscale = 1.f) {
    const int nblk = N / 32, kb = item / nblk, nb = item % nblk, k0 = 64 * kb, n0 = 32 * nb;
    const int j = n0 + (lane & 31);
    const float* Wp = W; int sc;
    if (MODE == 0) sc = coff + j;
    else if (MODE == 1) { const int jj = j & 255; Wp = jj < 128 ? W : W2; sc = 128 * (j >> 8) + (jj & 127); }
    else if (MODE == 2) {
        if (j < 1024) sc = (j >> 9) * 512 + ((j >> 6) & 7) * 64 + rope16_perm(j & 63);
        else if (j < 2048) sc = j;
        else if (j < 2432) sc = 3072 + (j - 2048);
        else if (j < 2688) sc = 3456 + (j - 2432);
        else if (j < 2720) sc = 3712 + rope8_perm(j - 2688);
        else sc = -1;
    } else if (MODE == 3) { const int hd = j / 96, d = j % 96; sc = hd * 96 + (d < 64 ? d : 64 + rope8_perm(d - 64)); }
    else if (MODE == 4) { if (j < 512) sc = (j >> 6) * 128 + (j & 63); else { const int jj = j - 512; sc = (jj >> 6) * 128 + 64 + (jj & 63); } }
    else sc = j;
#pragma unroll
    for (int i = 0; i < 32; ++i) {
        const int kk = 2 * i + (lane >> 5); int ks = k0 + kk;
        if (MODE == 5) { const int hd = ks / 96, d = ks % 96; ks = d < 64 ? hd * 64 + d : -1; }
        float v = 0.f; if (sc >= 0 && ks >= 0) v = Wp[(size_t)ks * Nsrc + sc];
        if (MODE == 0) v *= wscale;
        if (MODE == 1) v *= ((j & 255) < 128) ? LOG2E : (1.f / LOG2E);
        scr[kk * 33 + (lane & 31)] = v;
    }
    asm volatile("s_waitcnt lgkmcnt(0)" ::: "memory");
    const int c = lane & 7;
#pragma unroll
    for (int q = 0; q < 4; ++q) { const int n = (lane >> 3) + 8 * q; const float* s = scr + (8 * c) * 33 + n;
        u32x4 o; o.x = pk2(s[0], s[33]); o.y = pk2(s[66], s[99]); o.z = pk2(s[132], s[165]); o.w = pk2(s[198], s[231]);
        *(u32x4*)(WT + (size_t)(n0 + n) * Kd + k0 + 8 * c) = o; }
    asm volatile("s_waitcnt lgkmcnt(0)" ::: "memory");
}
__device__ __forceinline__ void phase_conv(const KArgs& a, uchar* lds, int l) {
    const int tid = otid(), lane = tid & 63, wave = tid >> 6;
    float* scr = (float*)(lds + wave * 16384);
    bf16_t* WB = (bf16_t*)(a.ws + WS_W);
    const int gw = blockIdx.x * 8 + wave, NGW = gridDim.x * 8;
    const float* f1w1 = a.in[6] + (size_t)l * DM * DFF; const float* f1w3 = a.in[7] + (size_t)l * DM * DFF; const float* f1w2 = a.in[8] + (size_t)l * DFF * DM;
    const float* f2w1 = a.in[9] + (size_t)l * DM * DFF; const float* f2w3 = a.in[10] + (size_t)l * DM * DFF; const float* f2w2 = a.in[11] + (size_t)l * DFF * DM;
    const float* win = a.in[12] + (size_t)l * DM * INW;
    const float* wuq = a.in[18] + (size_t)l * 384 * 768; const float* wukv = a.in[19] + (size_t)l * 256 * 1024;
    const float* wro = a.in[20] + (size_t)l * 1024 * 1024; const float* wmo = a.in[21] + (size_t)l * 512 * 1024; const float* wo = a.in[22] + (size_t)l * 1024 * 1024;
    constexpr int I_UP = 176 * 16, I_DN = 32 * 44, I_IN = 88 * 16, I_G = 32 * 16, I_UQ = 24 * 6, I_UKV = 32 * 4, I_MO = 32 * 8;
    constexpr int NIT = 2 * I_UP + 2 * I_DN + I_IN + 3 * I_G + I_UQ + I_UKV + I_G + I_MO + I_G;
    for (int it = gw; it < NIT; it += NGW) {
        int r = it;
        if (r < I_UP) { conv_item<1>(f1w1, f1w3, DFF, 5632, 1024, 0, WB + WE_UP1, scr, r, lane); continue; } r -= I_UP;
        if (r < I_DN) { conv_item<0>(f1w2, nullptr, DM, 1024, DFF, 0, WB + WE_DN1, scr, r, lane); continue; } r -= I_DN;
        if (r < I_UP) { conv_item<1>(f2w1, f2w3, DFF, 5632, 1024, 0, WB + WE_UP2, scr, r, lane); continue; } r -= I_UP;
        if (r < I_DN) { conv_item<0>(f2w2, nullptr, DM, 1024, DFF, 0, WB + WE_DN2, scr, r, lane); continue; } r -= I_DN;
        if (r < I_IN) { conv_item<2>(win, nullptr, INW, P1W, 1024, 0, WB + WE_IN, scr, r, lane); continue; } r -= I_IN;
        if (r < I_G) { conv_item<0>(win, nullptr, INW, 1024, 1024, 2048, WB + WE_G, scr, r, lane, LOG2E); continue; } r -= I_G;
        if (r < I_G) { conv_item<0>(win, nullptr, INW, 1024, 1024, 3744, WB + WE_GR, scr, r, lane, LOG2E); continue; } r -= I_G;
        if (r < I_G) { conv_item<0>(win, nullptr, INW, 1024, 1024, 4768, WB + WE_GM, scr, r, lane, LOG2E); continue; } r -= I_G;
        if (r < I_UQ) { conv_item<3>(wuq, nullptr, 768, 768, 384, 0, WB + WE_UQ, scr, r, lane); continue; } r -= I_UQ;
        if (r < I_UKV) { conv_item<4>(wukv, nullptr, 1024, 1024, 256, 0, WB + WE_UKV, scr, r, lane); continue; } r -= I_UKV;
        if (r < I_G) { conv_item<0>(wro, nullptr, 1024, 1024, 1024, 0, WB + WE_RO, scr, r, lane); continue; } r -= I_G;
        if (r < I_MO) { conv_item<0>(wmo, nullptr, 1024, 1024, 512, 0, WB + WE_MO, scr, r, lane); continue; } r -= I_MO;
        conv_item<0>(wo, nullptr, 1024, 1024, 1024, 0, WB + WE_WO, scr, r, lane);
    }
}
__device__ __forceinline__ void phase_norm(const float* xl, const float* xc, const float* mod, int shoff, bf16_t* XN, int M = MR) {
    const int tid = otid(), lane = tid & 63, gw = blockIdx.x * 8 + (tid >> 6), NGW = gridDim.x * 8;
    for (int row0 = gw; row0 < M; row0 += 2 * NGW) {
        const int row1 = row0 + NGW; const bool has1 = row1 < M;
        const float* src0 = row0 < TL ? xl + (size_t)row0 * DM : xc + (size_t)(row0 - TL) * DM;
        const float* src1 = has1 ? (row1 < TL ? xl + (size_t)row1 * DM : xc + (size_t)(row1 - TL) * DM) : src0;
        f32x4 v0[4], v1[4]; float s0 = 0.f, s1 = 0.f;
#pragma unroll
        for (int j = 0; j < 4; ++j) { v0[j] = *(const f32x4*)(src0 + 4 * lane + 256 * j); v1[j] = *(const f32x4*)(src1 + 4 * lane + 256 * j); }
#pragma unroll
        for (int j = 0; j < 4; ++j) { s0 += (v0[j].x * v0[j].x + v0[j].y * v0[j].y) + (v0[j].z * v0[j].z + v0[j].w * v0[j].w); s1 += (v1[j].x * v1[j].x + v1[j].y * v1[j].y) + (v1[j].z * v1[j].z + v1[j].w * v1[j].w); }
        const float r0 = 1.f / sqrtf(wave_sum(s0) * (1.f / DM) + EPSN), r1 = 1.f / sqrtf(wave_sum(s1) * (1.f / DM) + EPSN);
        const float* mp0 = mod + (row0 < TL ? (row0 >> 13) : 4) * NMOD + shoff; const float* mp1 = mod + (row1 < TL ? (row1 >> 13) : 4) * NMOD + shoff;
#pragma unroll
        for (int j = 0; j < 4; ++j) {
            const f32x4 sh = *(const f32x4*)(mp0 + 4 * lane + 256 * j), sc = *(const f32x4*)(mp0 + DM + 4 * lane + 256 * j);
            const f32x4 o = v0[j] * r0 * (sc + 1.f) + sh; u32x2 w; w.x = pk2(o.x, o.y); w.y = pk2(o.z, o.w);
            *(u32x2*)(XN + (size_t)row0 * DM + 4 * lane + 256 * j) = w;
        }
        if (has1) {
#pragma unroll
            for (int j = 0; j < 4; ++j) {
                const f32x4 sh = *(const f32x4*)(mp1 + 4 * lane + 256 * j), sc = *(const f32x4*)(mp1 + DM + 4 * lane + 256 * j);
                const f32x4 o = v1[j] * r1 * (sc + 1.f) + sh; u32x2 w; w.x = pk2(o.x, o.y); w.y = pk2(o.z, o.w);
                *(u32x2*)(XN + (size_t)row1 * DM + 4 * lane + 256 * j) = w;
            }
        }
    }
}
__device__ __forceinline__ void phase_final_norm(float* x, const float* gain) {
    const int tid = otid(), lane = tid & 63, gw = blockIdx.x * 8 + (tid >> 6), NGW = gridDim.x * 8;
    for (int row0 = gw; row0 < TL; row0 += 2 * NGW) {
        const int row1 = row0 + NGW; const bool has1 = row1 < TL;
        float* p0 = x + (size_t)row0 * DM; float* p1 = has1 ? x + (size_t)row1 * DM : p0;
        f32x4 v0[4], v1[4]; float s0 = 0.f, s1 = 0.f;
#pragma unroll
        for (int j = 0; j < 4; ++j) { v0[j] = *(const f32x4*)(p0 + 4 * lane + 256 * j); v1[j] = *(const f32x4*)(p1 + 4 * lane + 256 * j); }
#pragma unroll
        for (int j = 0; j < 4; ++j) { s0 += (v0[j].x * v0[j].x + v0[j].y * v0[j].y) + (v0[j].z * v0[j].z + v0[j].w * v0[j].w); s1 += (v1[j].x * v1[j].x + v1[j].y * v1[j].y) + (v1[j].z * v1[j].z + v1[j].w * v1[j].w); }
        const float r0 = 1.f / sqrtf(wave_sum(s0) * (1.f / DM) + EPSN), r1 = 1.f / sqrtf(wave_sum(s1) * (1.f / DM) + EPSN);
#pragma unroll
        for (int j = 0; j < 4; ++j) { const f32x4 g = *(const f32x4*)(gain + 4 * lane + 256 * j); *(f32x4*)(p0 + 4 * lane + 256 * j) = v0[j] * r0 * g; if (has1) *(f32x4*)(p1 + 4 * lane + 256 * j) = v1[j] * r1 * g; }
    }
}
__device__ __forceinline__ void phase_mla_prep(bf16_t* P1, const float* qn, const float* kvn) {
    const int tid = otid(), lane = tid & 63, gw = blockIdx.x * 8 + (tid >> 6), NGW = gridDim.x * 8;
    f32x4 gq0 = {}, gq1 = {}, gk0 = {}, gk1 = {};
    if (lane < 48) { gq0 = *(const f32x4*)(qn + 8 * lane); gq1 = *(const f32x4*)(qn + 8 * lane + 4); }
    if (lane < 32) { gk0 = *(const f32x4*)(kvn + 8 * lane); gk1 = *(const f32x4*)(kvn + 8 * lane + 4); }
    for (int rowb = gw; rowb < MR; rowb += 4 * NGW) {
        u32x4 wq[4], wk[4];
#pragma unroll
        for (int i = 0; i < 4; ++i) { const int row = rowb + i * NGW; wq[i] = (u32x4){0u, 0u, 0u, 0u}; wk[i] = wq[i];
            if (row < MR) { if (lane < 48) wq[i] = *(const u32x4*)(P1 + (size_t)row * P1W + 2048 + 8 * lane); if (lane < 32) wk[i] = *(const u32x4*)(P1 + (size_t)row * P1W + 2432 + 8 * lane); } }
#pragma unroll
        for (int i = 0; i < 4; ++i) { const int row = rowb + i * NGW;
            float q[8] = {bf_lo(wq[i].x), bf_hi(wq[i].x), bf_lo(wq[i].y), bf_hi(wq[i].y), bf_lo(wq[i].z), bf_hi(wq[i].z), bf_lo(wq[i].w), bf_hi(wq[i].w)};
            float k[8] = {bf_lo(wk[i].x), bf_hi(wk[i].x), bf_lo(wk[i].y), bf_hi(wk[i].y), bf_lo(wk[i].z), bf_hi(wk[i].z), bf_lo(wk[i].w), bf_hi(wk[i].w)};
            float sq = 0.f, sk = 0.f;
#pragma unroll
            for (int e = 0; e < 8; ++e) { sq += q[e] * q[e]; sk += k[e] * k[e]; }
            const float rq = 1.f / sqrtf(wave_sum(sq) * (1.f / 384.f) + EPSN), rk = 1.f / sqrtf(wave_sum(sk) * (1.f / 256.f) + EPSN);
            if (row < MR) {
                if (lane < 48) { u32x4 o; o.x = pk2(q[0] * rq * gq0.x, q[1] * rq * gq0.y); o.y = pk2(q[2] * rq * gq0.z, q[3] * rq * gq0.w); o.z = pk2(q[4] * rq * gq1.x, q[5] * rq * gq1.y); o.w = pk2(q[6] * rq * gq1.z, q[7] * rq * gq1.w);
                    *(u32x4*)(P1 + (size_t)row * P1W + 2048 + 8 * lane) = o; }
                if (lane < 32) { u32x4 o; o.x = pk2(k[0] * rk * gk0.x, k[1] * rk * gk0.y); o.y = pk2(k[2] * rk * gk0.z, k[3] * rk * gk0.w); o.z = pk2(k[4] * rk * gk1.x, k[5] * rk * gk1.y); o.w = pk2(k[6] * rk * gk1.z, k[7] * rk * gk1.w);
                    *(u32x4*)(P1 + (size_t)row * P1W + 2432 + 8 * lane) = o; }
            }
        }
    }
}

constexpr int TS = 272;
__device__ __forceinline__ void tstore_pair(uchar* T, int stride, int posb, int c8, u32x4 r0, u32x4 r1, int sw = 0) {
    uchar* p = T + (size_t)(8 * c8) * stride + posb * 2; (void)sw;
    *(unsigned*)(p + 0 * stride) = (r0.x & 0xffffu) | (r1.x << 16); *(unsigned*)(p + 1 * stride) = (r0.x >> 16) | (r1.x & 0xffff0000u);
    *(unsigned*)(p + 2 * stride) = (r0.y & 0xffffu) | (r1.y << 16); *(unsigned*)(p + 3 * stride) = (r0.y >> 16) | (r1.y & 0xffff0000u);
    *(unsigned*)(p + 4 * stride) = (r0.z & 0xffffu) | (r1.z << 16); *(unsigned*)(p + 5 * stride) = (r0.z >> 16) | (r1.z & 0xffff0000u);
    *(unsigned*)(p + 6 * stride) = (r0.w & 0xffffu) | (r1.w << 16); *(unsigned*)(p + 7 * stride) = (r0.w >> 16) | (r1.w & 0xffff0000u);
}
__device__ __forceinline__ u32x4 scale8(u32x4 w, float s) {
    u32x4 o; o.x = pk2(bf_lo(w.x) * s, bf_hi(w.x) * s); o.y = pk2(bf_lo(w.y) * s, bf_hi(w.y) * s); o.z = pk2(bf_lo(w.z) * s, bf_hi(w.z) * s); o.w = pk2(bf_lo(w.w) * s, bf_hi(w.w) * s); return o;
}
__device__ __forceinline__ void phase_r1(const bf16_t* P1, bf16_t* ST, bf16_t* CT, const float* dfw, const float* dbw, uchar* lds) {
    const int tid = otid(), lane = tid & 63, wave = tid >> 6, l32 = lane & 31, hi = lane >> 5;
    uchar* Tv = lds; uchar* Tkf = lds + 128 * TS; uchar* Tkb = Tkf + 64 * TS;
    const int kpa = tid >> 3, kc8 = tid & 7, j0 = 2 * kpa;
    u32x4 rv[4], rk[2];
#define R1_ROWS(u) ((u) < 2048 ? ((u) >> 9) * SEQ + ((u) & 63) * 128 : TL + (((u) - 2048) >> 4) * LCTX + (((u) - 2048) & 1) * 128)
#define R1_HEAD(u) ((u) < 2048 ? (((u) >> 6) & 7) : ((((u) - 2048) >> 1) & 7))
#define R1_LOAD(u) do { const int rows_ = R1_ROWS(u), h_ = R1_HEAD(u); const bf16_t* kp_ = P1 + (size_t)rows_ * P1W + 512 + h_ * 64; const bf16_t* vp_ = P1 + (size_t)rows_ * P1W + 1024 + h_ * 128; \
        _Pragma("unroll") for (int i = 0; i < 2; ++i) { const int task = tid + 512 * i, pa = task >> 4, c8 = task & 15; \
            rv[2 * i] = *(const u32x4*)(vp_ + (size_t)(2 * pa) * P1W + 8 * c8); rv[2 * i + 1] = *(const u32x4*)(vp_ + (size_t)(2 * pa + 1) * P1W + 8 * c8); } \
        rk[0] = *(const u32x4*)(kp_ + (size_t)j0 * P1W + 8 * kc8); rk[1] = *(const u32x4*)(kp_ + (size_t)(j0 + 1) * P1W + 8 * kc8); } while (0)
    int u = blockIdx.x;
    if (u < 2112) R1_LOAD(u);
    for (; u < 2112; u += gridDim.x) {
        int b, h; bf16_t* dstf; bf16_t* dstb;
        if (u < 2048) { b = u >> 9; h = (u >> 6) & 7; const int n = u & 63;
            dstf = ST + ((size_t)((0 * 4 + b) * 8 + h) * 64 + n) * 8192; dstb = ST + ((size_t)((1 * 4 + b) * 8 + h) * 64 + n) * 8192; }
        else { const int uc = u - 2048; b = uc >> 4; h = (uc >> 1) & 7; const int nc = uc & 1;
            dstf = CT + ((size_t)((0 * 4 + b) * 8 + h) * 2 + nc) * 8192; dstb = CT + ((size_t)((1 * 4 + b) * 8 + h) * 2 + nc) * 8192; }
        const float lgf = -expf(dfw[h]) * LOG2E, lgb = -expf(dbw[h]) * LOG2E;
#pragma unroll
        for (int i = 0; i < 2; ++i) { const int task = tid + 512 * i, pa = task >> 4, c8 = task & 15; tstore_pair(Tv, TS, (2 * pa & 64) + pos64(2 * pa & 63), c8, rv[2 * i], rv[2 * i + 1], c8); }
        { const int posb = (j0 & 64) + pos64(j0 & 63);
            tstore_pair(Tkf, TS, posb, kc8, scale8(rk[0], ex2(lgf * (float)(127 - j0))), scale8(rk[1], ex2(lgf * (float)(126 - j0))), kc8);
            tstore_pair(Tkb, TS, posb, kc8, scale8(rk[0], ex2(lgb * (float)j0)), scale8(rk[1], ex2(lgb * (float)(j0 + 1))), kc8); }
        __syncthreads();
        if (u + (int)gridDim.x < 2112) R1_LOAD(u + (int)gridDim.x);
        const int dir = wave >> 2, dvb = wave & 3;
        const uchar* Tk = dir ? Tkb : Tkf;
        f32x16 acc0 = {}, acc1 = {};
#pragma unroll
        for (int kk = 0; kk < 8; ++kk) {
            const bf16x8 av = *(const bf16x8*)(Tv + (dvb * 32 + l32) * TS + (16 * kk + 8 * hi) * 2);
            const bf16x8 b0 = *(const bf16x8*)(Tk + l32 * TS + (16 * kk + 8 * hi) * 2), b1 = *(const bf16x8*)(Tk + (32 + l32) * TS + (16 * kk + 8 * hi) * 2);
            acc0 = MFMA32(av, b0, acc0); acc1 = MFMA32(av, b1, acc1);
        }
        bf16_t* dst = dir ? dstb : dstf;
#pragma unroll
        for (int r = 0; r < 16; ++r) { bf16_t* p = dst + (dvb * 32 + crow(r, hi)) * 64 + l32; p[0] = (bf16_t)(pk2(acc0[r], 0.f) & 0xffffu); p[32] = (bf16_t)(pk2(acc1[r], 0.f) & 0xffffu); }
        __syncthreads();
    }
#undef R1_ROWS
#undef R1_HEAD
#undef R1_LOAD
}
__device__ __forceinline__ void phase_scan(bf16_t* ST, const bf16_t* CT, const float* dfw, const float* dbw, bool nostore = false) {
    const int gt = blockIdx.x * 512 + otid(), NT = gridDim.x * 512;
    for (int task = gt; task < 2 * 4 * 8 * 4096; task += NT) {
        const int e2 = task & 4095, bh = (task >> 12) & 31, dir = task >> 17, h = bh & 7;
        const float gC = ex2(-expf((dir ? dbw : dfw)[h]) * LOG2E * 128.f);
        unsigned* st = (unsigned*)(ST + ((size_t)(dir * 32 + bh) * 64) * 8192) + e2;
        const unsigned* ct = (const unsigned*)(CT + ((size_t)(dir * 32 + bh) * 2) * 8192) + e2;
        const unsigned c0 = ct[0], c1 = ct[4096];
        float s0, s1;
        if (dir == 0) { s0 = gC * bf_lo(c0) + bf_lo(c1); s1 = gC * bf_hi(c0) + bf_hi(c1); }
        else { s0 = gC * bf_lo(c1) + bf_lo(c0); s1 = gC * bf_hi(c1) + bf_hi(c0); }
#pragma unroll 16
        for (int step = 0; step < 64; ++step) {
            const int n = dir ? 63 - step : step;
            const unsigned t = st[(size_t)n * 4096];
            if (!nostore) st[(size_t)n * 4096] = pk2(s0, s1); else if (s0 == 123.456f) st[0] = 0u;
            s0 = gC * s0 + bf_lo(t); s1 = gC * s1 + bf_hi(t);
        }
    }
}
__device__ __forceinline__ void phase_r3(bf16_t* P1, const bf16_t* ST, const bf16_t* CT, const float* dfw, const float* dbw, const float* gn, uchar* lds, bool with_ctx, bool nostore = false) {
    const int tid = otid(), lane = tid & 63, wave = tid >> 6, l32 = lane & 31, hi = lane >> 5, grp = wave >> 2, ib = wave & 3, tg = tid & 255;
    uchar* Tv = lds + grp * (128 * TS);
    const int nunits = with_ctx ? 2112 : 2048, npairs = nunits / 2;
    for (int it = blockIdx.x; it < npairs; it += gridDim.x) {
        const int u = 2 * it + grp;
        int b, h, rows0; const bf16_t* stf; const bf16_t* stb;
        if (u < 2048) { b = u >> 9; h = (u >> 6) & 7; const int n = u & 63; rows0 = b * SEQ + n * 128;
            stf = ST + ((size_t)((0 * 4 + b) * 8 + h) * 64 + n) * 8192; stb = ST + ((size_t)((1 * 4 + b) * 8 + h) * 64 + n) * 8192; }
        else { const int uc = u - 2048; b = uc >> 4; h = (uc >> 1) & 7; const int nc = uc & 1; rows0 = TL + b * LCTX + nc * 128;
            stf = nc == 1 ? CT + ((size_t)((0 * 4 + b) * 8 + h) * 2 + 0) * 8192 : nullptr; stb = nc == 0 ? CT + ((size_t)((1 * 4 + b) * 8 + h) * 2 + 1) * 8192 : nullptr; }
        const float lgf = -expf(dfw[h]) * LOG2E, lgb = -expf(dbw[h]) * LOG2E;
        bf16_t* qp = P1 + (size_t)rows0 * P1W + h * 64; const bf16_t* kp = qp + 512; bf16_t* vp = P1 + (size_t)rows0 * P1W + 1024 + h * 128;
#pragma unroll
        for (int i = 0; i < 4; ++i) { const int task = tg + 256 * i, pa = task >> 4, c8 = task & 15;
            const u32x4 r0 = *(const u32x4*)(vp + (size_t)(2 * pa) * P1W + 8 * c8), r1 = *(const u32x4*)(vp + (size_t)(2 * pa + 1) * P1W + 8 * c8);
            tstore_pair(Tv, TS, (2 * pa & 64) + pos64(2 * pa & 63), c8, r0, r1, c8); }
        __syncthreads();
        int il_ = ib * 32 + l32; asm volatile("" : "+v"(il_)); const int il = il_;
        bf16x8 qf[4];
#pragma unroll
        for (int s = 0; s < 4; ++s) qf[s] = *(const bf16x8*)(qp + (size_t)il * P1W + 16 * s + 8 * hi);
        f32x16 sT[4];
#pragma unroll
        for (int jb = 0; jb < 4; ++jb) { sT[jb] = (f32x16){};
#pragma unroll
            for (int s = 0; s < 4; ++s) { const bf16x8 kf = *(const bf16x8*)(kp + (size_t)(jb * 32 + l32) * P1W + 16 * s + 8 * hi); sT[jb] = MFMA32(kf, qf[s], sT[jb]); }
            if (jb & 1) asm volatile("" ::: "memory"); }
        const float fdl = (float)(il - 4 * hi);
#pragma unroll
        for (int jb = 0; jb < 4; ++jb)
#pragma unroll
            for (int r = 0; r < 16; ++r) { const float fd = fdl - (float)(jb * 32 + (r & 3) + 8 * (r >> 2));
                const float e = ex2(fd * (fd > 0.f ? lgf : -lgb)); sT[jb][r] *= (fd == 0.f ? 2.f : e); }
        f32x16 oT[4] = {};
#pragma unroll
        for (int kk = 0; kk < 8; ++kk) {
            const int jb = kk >> 1, r0 = 8 * (kk & 1);
            const bf16x8 pf = pack8(sT[jb][r0], sT[jb][r0 + 1], sT[jb][r0 + 2], sT[jb][r0 + 3], sT[jb][r0 + 4], sT[jb][r0 + 5], sT[jb][r0 + 6], sT[jb][r0 + 7]);
#pragma unroll
            for (int dvb = 0; dvb < 4; ++dvb) { const bf16x8 av = *(const bf16x8*)(Tv + (dvb * 32 + l32) * TS + (16 * kk + 8 * hi) * 2); oT[dvb] = MFMA32(av, pf, oT[dvb]); }
            if (kk & 1) asm volatile("" ::: "memory");
        }
#pragma unroll
        for (int dir = 0; dir < 2; ++dir) {
            const bf16_t* sp = dir ? stb : stf;
#ifdef R3_NO_CROSS
            sp = nullptr;
#endif
            if (sp) {
                const float dec = dir ? ex2(lgb * (float)(128 - il)) : ex2(lgf * (float)(il + 1));
#pragma unroll
                for (int s = 0; s < 4; ++s) {
                    const bf16x8 qd = __builtin_bit_cast(bf16x8, scale8(__builtin_bit_cast(u32x4, qf[s]), dec));
#pragma unroll
                    for (int dvb = 0; dvb < 4; ++dvb) { const bf16x8 av = *(const bf16x8*)(sp + (dvb * 32 + l32) * 64 + 16 * s + 8 * hi); oT[dvb] = MFMA32(av, qd, oT[dvb]); }
                    if (s & 1) asm volatile("" ::: "memory");
                }
            }
        }
        float sm = 0.f;
#pragma unroll
        for (int dvb = 0; dvb < 4; ++dvb)
#pragma unroll
            for (int r = 0; r < 16; ++r) sm += oT[dvb][r];
        sm += __shfl_xor(sm, 32); const float mu = sm * (1.f / 128.f);
        float sq = 0.f;
#pragma unroll
        for (int dvb = 0; dvb < 4; ++dvb)
#pragma unroll
            for (int r = 0; r < 16; ++r) { const float d = oT[dvb][r] - mu; sq += d * d; }
        sq += __shfl_xor(sq, 32); const float rstd = 1.f / sqrtf(sq * (1.f / 128.f) + EPSN);
        const float* gp = gn + h * 128;
#pragma unroll
        for (int dvb = 0; dvb < 4; ++dvb)
#pragma unroll
            for (int rq = 0; rq < 4; ++rq) { const int dv = 32 * dvb + 8 * rq + 4 * hi; const f32x4 g = *(const f32x4*)(gp + dv) * (1.f / LOG2E);
                u32x2 w; w.x = pk2((oT[dvb][4 * rq] - mu) * rstd * g.x, (oT[dvb][4 * rq + 1] - mu) * rstd * g.y); w.y = pk2((oT[dvb][4 * rq + 2] - mu) * rstd * g.z, (oT[dvb][4 * rq + 3] - mu) * rstd * g.w);
                if (!nostore || w.x == 0x12345678u) *(u32x2*)(vp + (size_t)il * P1W + dv) = w; if (rq == 3) asm volatile("" ::: "memory"); }
        __syncthreads();
    }
}

constexpr int KROW = 208, VROW = 144, KT_BYTES = 64 * KROW, VT_BYTES = 64 * VROW;
__device__ __forceinline__ void attn_unit(const bf16_t* Qm, const bf16_t* KVm, const bf16_t* P1, bf16_t* OP, int q0, int h, int klat, int nlat, int kctx, int nt, uchar* lds) {
    const int tid = otid(), lane = tid & 63, wave = tid >> 6, l32 = lane & 31, hi = lane >> 5;
    uchar* Kt = lds; uchar* Vt = lds + 2 * KT_BYTES;
    const bf16_t* qrow = Qm + (size_t)(q0 + wave * 32 + l32) * QMW + h * 96;
    bf16_t* orow = OP + (size_t)(q0 + wave * 32 + l32) * P1W + 2048 + h * 64;
    bf16x8 qf[6];
#pragma unroll
    for (int s = 0; s < 6; ++s) qf[s] = *(const bf16x8*)(qrow + 16 * s + 8 * hi);
    const int kr0 = tid / 12, kc0 = tid % 12, kr1 = (512 + tid) / 12, kc1 = (512 + tid) % 12;
    const int tv = tid - 256, va = tv >> 3, vc8 = tv & 7;
    u32x4 xk0, xa = (u32x4){0u, 0u, 0u, 0u}, xb = xa;
#define TILE_ROW(j) ((j) < nlat ? klat + 64 * (j) : kctx + 64 * ((j) - nlat))
#define LOADK(j) do { const int kb_ = TILE_ROW(j); \
        xk0 = kc0 < 8 ? *(const u32x4*)(KVm + (size_t)(kb_ + kr0) * KVW + h * 64 + 8 * kc0) : *(const u32x4*)(P1 + (size_t)(kb_ + kr0) * P1W + 2688 + 8 * (kc0 - 8)); \
        if (tid < 256) { xa = kc1 < 8 ? *(const u32x4*)(KVm + (size_t)(kb_ + kr1) * KVW + h * 64 + 8 * kc1) : *(const u32x4*)(P1 + (size_t)(kb_ + kr1) * P1W + 2688 + 8 * (kc1 - 8)); } } while (0)
#define LOADV(j) do { if (tid >= 256) { const int kb_ = TILE_ROW(j); \
        xa = *(const u32x4*)(KVm + (size_t)(kb_ + 2 * va) * KVW + 512 + h * 64 + 8 * vc8); xb = *(const u32x4*)(KVm + (size_t)(kb_ + 2 * va + 1) * KVW + 512 + h * 64 + 8 * vc8); } } while (0)
#define STOREK(buf) do { *(u32x4*)(Kt + (buf) * KT_BYTES + kr0 * KROW + kc0 * 16) = xk0; if (tid < 256) { *(u32x4*)(Kt + (buf) * KT_BYTES + kr1 * KROW + kc1 * 16) = xa; } } while (0)
#define STOREV(buf) do { if (tid >= 256) { tstore_pair(Vt + (buf) * VT_BYTES, VROW, pos64(2 * va), vc8, xa, xb); } } while (0)
    LOADK(0); LOADV(0); STOREK(0); STOREV(0); LOADK(1); STOREK(1);
    __syncthreads();
    f32x16 negm = {}, s0 = {}, s1 = {};
    { const uchar* kb = Kt + l32 * KROW + hi * 16;
#pragma unroll
      for (int s = 0; s < 6; ++s) { const bf16x8 a0 = *(const bf16x8*)(kb + s * 32), a1 = *(const bf16x8*)(kb + 32 * KROW + s * 32); s0 = MFMA32(a0, qf[s], s0); s1 = MFMA32(a1, qf[s], s1); } }
    __syncthreads();
    float mref = 0.f, lsum = 0.f; f32x16 o0 = {}, o1 = {};
    for (int t = 0; t < nt; ++t) {
        const int buf = t & 1;
        if (t + 2 < nt) LOADK(t + 2);
        if (t + 1 < nt) LOADV(t + 1);
        float ra = fmaxf(fmaxf(s0[0], s0[1]), s1[0]), rb = fmaxf(fmaxf(s0[2], s0[3]), s1[1]); ra = fmaxf(fmaxf(ra, s1[2]), s1[3]);
#pragma unroll
        for (int r = 4; r < 16; r += 4) { ra = fmaxf(fmaxf(ra, s0[r]), s0[r + 1]); rb = fmaxf(fmaxf(rb, s0[r + 2]), s0[r + 3]); ra = fmaxf(fmaxf(ra, s1[r]), s1[r + 1]); rb = fmaxf(fmaxf(rb, s1[r + 2]), s1[r + 3]); }
        float rm = fmaxf(ra, rb); rm = fmaxf(rm, __shfl_xor(rm, 32));
        if (t == 0 || __any(rm > 8.f)) {
            const float dl = t == 0 ? rm : fmaxf(rm, 0.f); mref += dl; const float f = ex2(fminf(-dl, 64.f)); lsum *= f; o0 *= f; o1 *= f; s0 -= dl; s1 -= dl;
#pragma unroll
            for (int r = 0; r < 16; ++r) negm[r] = -mref;
        }
        f32x16 n0 = negm, n1 = negm;
        { const uchar* kb = Kt + (buf ^ 1) * KT_BYTES + l32 * KROW + hi * 16;
#pragma unroll
          for (int s = 0; s < 6; ++s) { const bf16x8 a0 = *(const bf16x8*)(kb + s * 32), a1 = *(const bf16x8*)(kb + 32 * KROW + s * 32); n0 = MFMA32(a0, qf[s], n0); n1 = MFMA32(a1, qf[s], n1); } }
        float ps = 0.f;
#pragma unroll
        for (int r = 0; r < 16; ++r) { s0[r] = ex2(s0[r]); s1[r] = ex2(s1[r]); ps += s0[r] + s1[r]; }
        lsum += ps;
        const uchar* vb = Vt + buf * VT_BYTES + l32 * VROW + hi * 16;
#pragma unroll
        for (int kk = 0; kk < 4; ++kk) {
            const int r0 = 8 * (kk & 1);
            const bf16x8 pf = (kk >> 1) ? pack8(s1[r0], s1[r0 + 1], s1[r0 + 2], s1[r0 + 3], s1[r0 + 4], s1[r0 + 5], s1[r0 + 6], s1[r0 + 7])
                                        : pack8(s0[r0], s0[r0 + 1], s0[r0 + 2], s0[r0 + 3], s0[r0 + 4], s0[r0 + 5], s0[r0 + 6], s0[r0 + 7]);
            const bf16x8 a0 = *(const bf16x8*)(vb + kk * 32), a1 = *(const bf16x8*)(vb + 32 * VROW + kk * 32);
            o0 = MFMA32(a0, pf, o0); o1 = MFMA32(a1, pf, o1);
        }
        if (t + 2 < nt) STOREK(buf);
        if (t + 1 < nt) STOREV(buf ^ 1);
        __syncthreads();
        s0 = n0; s1 = n1;
    }
#undef TILE_ROW
#undef LOADK
#undef LOADV
#undef STOREK
#undef STOREV
    lsum += __shfl_xor(lsum, 32); const float inv = 1.f / lsum;
#pragma unroll
    for (int rq = 0; rq < 4; ++rq) {
        u32x2 w; w.x = pk2(o0[4 * rq] * inv, o0[4 * rq + 1] * inv); w.y = pk2(o0[4 * rq + 2] * inv, o0[4 * rq + 3] * inv);
        *(u32x2*)(orow + 8 * rq + 4 * hi) = w;
        w.x = pk2(o1[4 * rq] * inv, o1[4 * rq + 1] * inv); w.y = pk2(o1[4 * rq + 2] * inv, o1[4 * rq + 3] * inv);
        *(u32x2*)(orow + 32 + 8 * rq + 4 * hi) = w;
    }
}

__device__ __forceinline__ void attn_unit2(const bf16_t* Qm, const bf16_t* KVm, const bf16_t* P1, bf16_t* OP, int q0, int h, int klat, int nlat, int kctx, int nt, uchar* lds, bool nostore = false) {
    const int tid = otid(), lane = tid & 63, wave = tid >> 6, l32 = lane & 31, hi = lane >> 5;
    uchar* Kt = lds; uchar* Vt = lds + 2 * KT_BYTES;
    const bf16_t* qrowA = Qm + (size_t)(q0 + wave * 64 + l32) * QMW + h * 96; const bf16_t* qrowB = qrowA + (size_t)32 * QMW;
    bf16_t* orowA = OP + (size_t)(q0 + wave * 64 + l32) * P1W + 2048 + h * 64; bf16_t* orowB = orowA + (size_t)32 * P1W;
    bf16x8 qa[6], qb[6];
#pragma unroll
    for (int s = 0; s < 6; ++s) { qa[s] = *(const bf16x8*)(qrowA + 16 * s + 8 * hi); qb[s] = *(const bf16x8*)(qrowB + 16 * s + 8 * hi); }
    const int kr0 = tid / 12, kc0 = tid % 12, kr1 = (512 + tid) / 12, kc1 = (512 + tid) % 12;
    const int tv = tid - 256, va = tv >> 3, vc8 = tv & 7;
    u32x4 xk0, xa = (u32x4){0u, 0u, 0u, 0u}, xb = xa;
#define TILE_ROW(j) ((j) < nlat ? klat + 64 * (j) : kctx + 64 * ((j) - nlat))
#define LOADKV(j) do { const int kb_ = TILE_ROW(j); \
        xk0 = kc0 < 8 ? *(const u32x4*)(KVm + (size_t)(kb_ + kr0) * KVW + h * 64 + 8 * kc0) : *(const u32x4*)(P1 + (size_t)(kb_ + kr0) * P1W + 2688 + 8 * (kc0 - 8)); \
        if (tid < 256) { xa = kc1 < 8 ? *(const u32x4*)(KVm + (size_t)(kb_ + kr1) * KVW + h * 64 + 8 * kc1) : *(const u32x4*)(P1 + (size_t)(kb_ + kr1) * P1W + 2688 + 8 * (kc1 - 8)); } \
        else { xa = *(const u32x4*)(KVm + (size_t)(kb_ + 2 * va) * KVW + 512 + h * 64 + 8 * vc8); xb = *(const u32x4*)(KVm + (size_t)(kb_ + 2 * va + 1) * KVW + 512 + h * 64 + 8 * vc8); } } while (0)
#define STOREKV(buf) do { *(u32x4*)(Kt + (buf) * KT_BYTES + kr0 * KROW + kc0 * 16) = xk0; \
        if (tid < 256) { *(u32x4*)(Kt + (buf) * KT_BYTES + kr1 * KROW + kc1 * 16) = xa; } \
        else { tstore_pair(Vt + (buf) * VT_BYTES, VROW, pos64(2 * va), vc8, xa, xb); } } while (0)
    LOADKV(0); STOREKV(0);
    __syncthreads();
    float mA = -1e30f, mB = -1e30f, lA = 0.f, lB = 0.f; f32x16 oA0 = {}, oA1 = {}, oB0 = {}, oB1 = {};
    for (int t = 0; t < nt; ++t) {
        const int buf = t & 1;
        if (t + 1 < nt) LOADKV(t + 1);
        f32x16 sA0 = {}, sA1 = {}, sB0 = {}, sB1 = {};
        { const uchar* kb = Kt + buf * KT_BYTES + l32 * KROW + hi * 16;
#pragma unroll
          for (int s = 0; s < 6; ++s) { const bf16x8 a0 = *(const bf16x8*)(kb + s * 32), a1 = *(const bf16x8*)(kb + 32 * KROW + s * 32);
              sA0 = MFMA32(a0, qa[s], sA0); sA1 = MFMA32(a1, qa[s], sA1); sB0 = MFMA32(a0, qb[s], sB0); sB1 = MFMA32(a1, qb[s], sB1); } }
#define SOFTMAX_BLK(S0, S1, M, L, O0, O1) do { \
        float ra = fmaxf(fmaxf(S0[0], S0[1]), S1[0]), rb = fmaxf(fmaxf(S0[2], S0[3]), S1[1]); ra = fmaxf(fmaxf(ra, S1[2]), S1[3]); \
        _Pragma("unroll") for (int r = 4; r < 16; r += 4) { ra = fmaxf(fmaxf(ra, S0[r]), S0[r + 1]); rb = fmaxf(fmaxf(rb, S0[r + 2]), S0[r + 3]); ra = fmaxf(fmaxf(ra, S1[r]), S1[r + 1]); rb = fmaxf(fmaxf(rb, S1[r + 2]), S1[r + 3]); } \
        float rm = fmaxf(ra, rb); rm = fmaxf(rm, __shfl_xor(rm, 32)); \
        if (__any(rm > M + 8.f)) { const float mn = fmaxf(M, rm), f = ex2(M - mn); M = mn; L *= f; O0 *= f; O1 *= f; } \
        float ps = 0.f; \
        _Pragma("unroll") for (int r = 0; r < 16; ++r) { S0[r] = ex2(S0[r] - M); S1[r] = ex2(S1[r] - M); ps += S0[r] + S1[r]; } \
        L += ps; } while (0)
        SOFTMAX_BLK(sA0, sA1, mA, lA, oA0, oA1);
        SOFTMAX_BLK(sB0, sB1, mB, lB, oB0, oB1);
        const uchar* vb = Vt + buf * VT_BYTES + l32 * VROW + hi * 16;
#pragma unroll
        for (int kk = 0; kk < 4; ++kk) {
            const int r0 = 8 * (kk & 1);
            const bf16x8 pa = (kk >> 1) ? pack8(sA1[r0], sA1[r0 + 1], sA1[r0 + 2], sA1[r0 + 3], sA1[r0 + 4], sA1[r0 + 5], sA1[r0 + 6], sA1[r0 + 7])
                                        : pack8(sA0[r0], sA0[r0 + 1], sA0[r0 + 2], sA0[r0 + 3], sA0[r0 + 4], sA0[r0 + 5], sA0[r0 + 6], sA0[r0 + 7]);
            const bf16x8 pb = (kk >> 1) ? pack8(sB1[r0], sB1[r0 + 1], sB1[r0 + 2], sB1[r0 + 3], sB1[r0 + 4], sB1[r0 + 5], sB1[r0 + 6], sB1[r0 + 7])
                                        : pack8(sB0[r0], sB0[r0 + 1], sB0[r0 + 2], sB0[r0 + 3], sB0[r0 + 4], sB0[r0 + 5], sB0[r0 + 6], sB0[r0 + 7]);
            const bf16x8 a0 = *(const bf16x8*)(vb + kk * 32), a1 = *(const bf16x8*)(vb + 32 * VROW + kk * 32);
            oA0 = MFMA32(a0, pa, oA0); oA1 = MFMA32(a1, pa, oA1); oB0 = MFMA32(a0, pb, oB0); oB1 = MFMA32(a1, pb, oB1);
        }
        if (t + 1 < nt) STOREKV(buf ^ 1);
        __syncthreads();
    }
#undef SOFTMAX_BLK
#undef TILE_ROW
#undef LOADKV
#undef STOREKV
    lA += __shfl_xor(lA, 32); lB += __shfl_xor(lB, 32); const float iA = 1.f / lA, iB = 1.f / lB;
    if (nostore && iA != 123.456f) return;
#pragma unroll
    for (int rq = 0; rq < 4; ++rq) {
        u32x2 w; w.x = pk2(oA0[4 * rq] * iA, oA0[4 * rq + 1] * iA); w.y = pk2(oA0[4 * rq + 2] * iA, oA0[4 * rq + 3] * iA); *(u32x2*)(orowA + 8 * rq + 4 * hi) = w;
        w.x = pk2(oA1[4 * rq] * iA, oA1[4 * rq + 1] * iA); w.y = pk2(oA1[4 * rq + 2] * iA, oA1[4 * rq + 3] * iA); *(u32x2*)(orowA + 32 + 8 * rq + 4 * hi) = w;
        w.x = pk2(oB0[4 * rq] * iB, oB0[4 * rq + 1] * iB); w.y = pk2(oB0[4 * rq + 2] * iB, oB0[4 * rq + 3] * iB); *(u32x2*)(orowB + 8 * rq + 4 * hi) = w;
        w.x = pk2(oB1[4 * rq] * iB, oB1[4 * rq + 1] * iB); w.y = pk2(oB1[4 * rq + 2] * iB, oB1[4 * rq + 3] * iB); *(u32x2*)(orowB + 32 + 8 * rq + 4 * hi) = w;
    }
}
__device__ __forceinline__ void phase_attn(const bf16_t* Qm, const bf16_t* KVm, bf16_t* P1, uchar* lds, bool with_ctx, bool nostore = false) {
    const int c = blockIdx.x, G = gridDim.x;
#ifdef ATT_R64
    for (int uidx = c; uidx < 512; uidx += G) {
        int bh, qb;
        if (G == 256) { bh = 16 * (uidx >> 8) + 2 * (c & 7) + (c >> 7); qb = (c >> 3) & 15; } else { bh = uidx >> 4; qb = uidx & 15; }
        const int b = bh >> 3, h = bh & 7;
        attn_unit2(Qm, KVm, P1, P1, b * SEQ + qb * 512, h, b * SEQ, 128, TL + b * LCTX, 132, lds, nostore);
    }
#else
    for (int uidx = c; uidx < 1024; uidx += G) {
        int bh, qb;
        if (G == 256) { bh = 8 * (uidx >> 8) + (c & 7); qb = c >> 3; } else { bh = uidx >> 5; qb = uidx & 31; }
        const int b = bh >> 3, h = bh & 7;
        attn_unit(Qm, KVm, P1, P1, b * SEQ + qb * 256, h, b * SEQ, 128, TL + b * LCTX, 132, lds);
    }
#endif
    if (with_ctx && !nostore) for (int uidx = (G >= 64 ? c - 32 : c); uidx >= 0 && uidx < 32; uidx += G) { const int b = uidx >> 3, h = uidx & 7; attn_unit(Qm, KVm, P1, P1, TL + b * LCTX, h, 0, 0, TL + b * LCTX, 4, lds); }
}

#define LAS __attribute__((address_space(3)))
#define XB_TMO      128
#define XB_XCNT(j)  (256  + 64 * (j))
#define XB_XSUB(j)  (1280 + 64 * (j))
#define XB_XGEN(j)  (2304 + 64 * (j))
#define XB_TOP      3328
#define XB_TOPGEN   3392
#define XCD_BAR_WORDS 3456
#define XB_SPIN_CAP (1u << 18)

__device__ __forceinline__ unsigned xb_ld(unsigned* p)              { return __hip_atomic_load(p, __ATOMIC_RELAXED, __HIP_MEMORY_SCOPE_AGENT); }
__device__ __forceinline__ unsigned xb_add(unsigned* p, unsigned v) { return __hip_atomic_fetch_add(p, v, __ATOMIC_RELAXED, __HIP_MEMORY_SCOPE_AGENT); }
__device__ __forceinline__ unsigned xb_xcc_id() { return (unsigned)__builtin_amdgcn_s_getreg((3 << 11) | 20) & 0xFu; }
#define XB_SPIN(cond, bar) do { unsigned _sp = 0; while (cond) { __builtin_amdgcn_s_sleep(1); \
    if ((++_sp & 255u) == 0u) { if (xb_ld(&(bar)[XB_TMO])) break; if (_sp > XB_SPIN_CAP) { atomicAdd(&(bar)[XB_TMO], 1u); break; } } } } while (0)

struct XcdBarrier {
    unsigned* bar; unsigned x;
    volatile LAS unsigned* st;
};

__device__ __forceinline__ XcdBarrier xcd_barrier_post(unsigned* bar, volatile LAS unsigned* st) {
    XcdBarrier b; b.bar = bar; b.x = xb_xcc_id(); b.st = st;
    if (threadIdx.x == 0) (void)xb_add(&bar[XB_XCNT(b.x)], 1u);
    return b;
}
__device__ __forceinline__ void xcd_barrier_complete(unsigned* bar, unsigned x, unsigned& nloc, unsigned& nx) {
    const unsigned G = gridDim.x * gridDim.y * gridDim.z;
    unsigned sum, cnt, mine, sp = 0u;
    for (;;) {
        sum = 0u; cnt = 0u; mine = 0u;
#pragma unroll
        for (unsigned j = 0; j < 16; ++j) { const unsigned c = xb_ld(&bar[XB_XCNT(j)]); sum += c; cnt += (c > 0u) ? 1u : 0u; mine = (j == x) ? c : mine; }
        if (sum == G) break;
        __builtin_amdgcn_s_sleep(1);
        if ((++sp & 255u) == 0u) { if (xb_ld(&bar[XB_TMO])) break; if (sp > XB_SPIN_CAP) { atomicAdd(&bar[XB_TMO], 1u); break; } }
    }
    nloc = mine > 0u ? mine : 1u; nx = cnt > 0u ? cnt : 1u;
}

__device__ __forceinline__ void xcd_barrier(const XcdBarrier& b) {
    asm volatile("s_waitcnt vmcnt(0)" ::: "memory");
    __syncthreads();
    if (threadIdx.x == 0) {
        unsigned* bar = b.bar;
        __builtin_amdgcn_s_waitcnt(0);
        unsigned nloc = b.st[0], nx = b.st[1];
        if (nloc == 0u) { xcd_barrier_complete(bar, b.x, nloc, nx); b.st[0] = nloc; b.st[1] = nx; }
        const unsigned old = xb_add(&bar[XB_XSUB(b.x)], 1u);
        const unsigned gen = old / nloc;
        if (old + 1u == (gen + 1u) * nloc) {
            __builtin_amdgcn_fence(__ATOMIC_RELEASE, "agent");
            asm volatile("s_waitcnt vmcnt(0)" ::: "memory");
            const unsigned og = xb_add(&bar[XB_TOP], 1u);
            const unsigned tg = og / nx;
            if (og + 1u == (tg + 1u) * nx) xb_add(&bar[XB_TOPGEN], 1u);
            else XB_SPIN(xb_ld(&bar[XB_TOPGEN]) == tg, bar);
            __builtin_amdgcn_fence(__ATOMIC_ACQUIRE, "agent");
            xb_add(&bar[XB_XGEN(b.x)], 1u);
            asm volatile("s_waitcnt vmcnt(0)" ::: "memory");
        } else {
            XB_SPIN(xb_ld(&bar[XB_XGEN(b.x)]) == gen, bar);
            __builtin_amdgcn_fence(__ATOMIC_ACQUIRE, "agent");
            asm volatile("s_waitcnt vmcnt(0)" ::: "memory");
        }
    }
    __syncthreads();
}

constexpr int NPHASE = 30;
template <class Epi> __device__ __forceinline__ void run_gemm(uchar* lds, const bf16_t* A, int lda, const bf16_t* Bt, int N, int K, const Epi& E, int M = MR) {
    pg8::Gemm g{A, Bt, M, N, K, lda}; pg8::StaticOrder S; S.init(M, N, (int)gridDim.x, (int)blockIdx.x);
    pg8::gemm_phase<Epi, pg8::StaticOrder, PG8_ALIGN_EPI, PG8_SP2_K>((PG8_LAS unsigned char*)lds, g, S, E);
}
__global__ void __launch_bounds__(512, 2) mk_fwd(KArgs a) {
    extern __shared__ __attribute__((aligned(16))) unsigned char lds[];
    cg::grid_group grid = cg::this_grid();
    unsigned char* ws = a.ws;
    float* XC = (float*)(ws + WS_XC); const float* MOD = (const float*)(ws + WS_MOD); const float* RT = (const float*)(ws + WS_ROPE);
    bf16_t* WB = (bf16_t*)(ws + WS_W); bf16_t* XN = (bf16_t*)(ws + WS_XN); bf16_t* PA = (bf16_t*)(ws + WS_A);
    bf16_t* ST = (bf16_t*)(ws + WS_ST); bf16_t* CT = (bf16_t*)(ws + WS_CT); bf16_t* QM = (bf16_t*)(ws + WS_QM); bf16_t* KVM = (bf16_t*)(ws + WS_KVM);
    float* XL = a.out;
    const int lo = a.ph_lo, hi = a.ph_hi;
    volatile LAS unsigned* ldsctl = (volatile LAS unsigned*)((LAS unsigned char*)lds + 139264);
    if (threadIdx.x < 2) ldsctl[threadIdx.x] = 0u;
    __syncthreads();
    XcdBarrier bar; bar.bar = (unsigned*)(ws + WS_CTL); bar.x = 0; bar.st = ldsctl;
    if (hi - lo > 1) bar = xcd_barrier_post((unsigned*)(ws + WS_CTL), ldsctl);
#ifdef PH_ONLY
#define PH_ON(rel) ((rel) == PH_ONLY)
#else
#define PH_ON(rel) true
#endif
#ifndef SKIP_SCAN
#define SKIP_SCAN 0
#endif
#ifndef SKIP_R3
#define SKIP_R3 0
#endif
#ifndef MIX_VARIANT
#define MIX_VARIANT 0
#endif
#ifndef PH_LIMIT
#define PH_LIMIT 100
#endif
#define PH_BEGIN(k) if (lo <= (k) && (k) < hi && ((k) < PH_LIMIT || (k) == 29) && PH_ON((k) == 0 ? 0 : ((k) == 29 ? 15 : (k) - pb + 1))) {
#ifndef PH_SUB
#define PH_SUB 255
#endif
#define SUB(n) ((PH_SUB >> (n)) & 1)
#ifdef PROBE_BAR2
#define PH_END(k) if ((k) + 1 < hi) { if ((k) == 0) grid.sync(); else { xcd_barrier(bar); xcd_barrier(bar); } } }
#else
#define PH_END(k) if ((k) + 1 < hi) { if ((k) == 0) grid.sync(); else xcd_barrier(bar); } }
#endif
    { const int pb = 1; PH_BEGIN(0) phase_mods(a, lds); __syncthreads(); phase_conv(a, lds, 0); PH_END(0) }
    for (int l = 0; l < 2; ++l) {
        const int pb = 1 + 14 * l;
        const float* mod = MOD + (size_t)l * 5 * NMOD;
        const float* xl_in = l == 0 ? a.in[0] : XL; const float* xc_in = l == 0 ? a.in[2] : XC;
        const float* dfw = a.in[13] + l * 8; const float* dbw = a.in[14] + l * 8;
        const int ML = l == 1 ? TL : MR;
        PH_BEGIN(pb + 0) if (l > 0) phase_conv(a, lds, l); phase_norm(xl_in, xc_in, mod, 0, XN); PH_END(pb + 0)
        PH_BEGIN(pb + 1) run_gemm(lds, XN, DM, WB + WE_UP1, 5632, DM, EpiUp{PA});
#ifdef PROBE_UP2X
            run_gemm(lds, XN, DM, WB + WE_UP1, 5632, DM, EpiUp{PA});
#endif
        PH_END(pb + 1)
        PH_BEGIN(pb + 2) run_gemm(lds, PA, DFF, WB + WE_DN1, DM, DFF, EpiRes{xl_in, xc_in, XL, XC, mod + 2048, 0.5f}, TL);
            ctx_gemm(PA + (size_t)TL * DFF, DFF, WB + WE_DN1, DFF, FinRes{xc_in, XC, mod + 4 * NMOD + 2048, 0.5f}, lds); PH_END(pb + 2)
        PH_BEGIN(pb + 3) phase_norm(XL, XC, mod, 3072, XN); PH_END(pb + 3)
        PH_BEGIN(pb + 4) run_gemm(lds, XN, DM, WB + WE_IN, P1W, DM, EpiRope<false>{PA, RT, RT + 2048, RT + 4096, RT + 5120}); PH_END(pb + 4)
        PH_BEGIN(pb + 5) phase_r1(PA, ST, CT, dfw, dbw, lds);
#ifdef PROBE_RET
            phase_r1(PA, ST, CT, dfw, dbw, lds);
#endif
 phase_mla_prep(PA, a.in[16] + l * 384, a.in[17] + l * 256); PH_END(pb + 5)
        PH_BEGIN(pb + 6)
#ifdef PROBE_RET
            phase_scan(ST, CT, dfw, dbw, a.ph_hi > 0);
#endif
            if (SUB(0) && !SKIP_SCAN) phase_scan(ST, CT, dfw, dbw, a.ph_hi < 0);
            if (SUB(1)) run_gemm(lds, PA + 2048, P1W, WB + WE_UQ, QMW, 384, EpiRope<true>{QM, RT, RT + 2048, RT + 4096, RT + 5120}, ML);
            run_gemm(lds, PA + 2432, P1W, WB + WE_UKV, KVW, 256, EpiBf<0>{KVM, KVW, nullptr, 0}, TL);
            ctx_gemm(PA + (size_t)TL * P1W + 2432, P1W, WB + WE_UKV, 256, FinBf<0>{KVM + (size_t)TL * KVW, KVW, nullptr, 0}, lds); PH_END(pb + 6)
        PH_BEGIN(pb + 7)
#ifdef PROBE_ATT
            phase_attn(QM, KVM, PA, lds, l == 0, a.ph_hi > 0); __syncthreads();
#endif
            if (SUB(0)) phase_attn(QM, KVM, PA, lds, l == 0, a.ph_hi < 0); __syncthreads();
#ifdef PROBE_RET
            phase_r3(PA, ST, CT, dfw, dbw, a.in[15] + l * 1024, lds, l == 0, a.ph_hi > 0);
#endif
            if (SUB(1) && !SKIP_R3) phase_r3(PA, ST, CT, dfw, dbw, a.in[15] + l * 1024, lds, l == 0, a.ph_hi < 0); PH_END(pb + 7)
        bf16_t* PAc = PA + (size_t)TL * P1W; const bf16_t* XNc = XN + (size_t)TL * DM; bf16_t* KVMc = KVM + (size_t)TL * KVW;
        PH_BEGIN(pb + 8) run_gemm(lds, XN, DM, WB + WE_G, DM, DM, EpiBf<1>{PA + 1024, P1W, nullptr, 0}, TL);
            if (l == 0) ctx_gemm(XNc, DM, WB + WE_G, DM, FinBf<1>{PAc + 1024, P1W, nullptr, 0}, lds); PH_END(pb + 8)
        PH_BEGIN(pb + 9)
            run_gemm(lds, PA + 1024, P1W, WB + WE_RO, DM, DM, EpiBf<0>{PA, P1W, nullptr, 0}, TL);
            run_gemm(lds, XN, DM, WB + WE_GR, DM, DM, EpiBf<2>{PA, P1W, nullptr, 0}, TL);
            run_gemm(lds, PA + 2048, P1W, WB + WE_MO, DM, 512, EpiBf<0>{KVM, KVW, nullptr, 0}, TL);
            run_gemm(lds, XN, DM, WB + WE_GM, DM, DM, EpiBf<3>{PA, P1W, KVM, KVW}, TL);
            if (l == 0) {
                ctx_gemm(PAc + 1024, P1W, WB + WE_RO, DM, FinBf<0>{PAc, P1W, nullptr, 0}, lds);
                ctx_gemm(XNc, DM, WB + WE_GR, DM, FinBf<2>{PAc, P1W, nullptr, 0}, lds);
                ctx_gemm(PAc + 2048, P1W, WB + WE_MO, 512, FinBf<0>{KVMc, KVW, nullptr, 0}, lds);
                ctx_gemm(XNc, DM, WB + WE_GM, DM, FinBf<3>{PAc, P1W, KVMc, KVW}, lds);
            }
        PH_END(pb + 9)
        PH_BEGIN(pb + 10) run_gemm(lds, PA, P1W, WB + WE_WO, DM, DM, EpiRes{XL, XC, XL, XC, mod + 5120, 1.0f}, TL);
            if (l == 0) ctx_gemm(PA + (size_t)TL * P1W, P1W, WB + WE_WO, DM, FinRes{XC, XC, mod + 4 * NMOD + 5120, 1.0f}, lds); PH_END(pb + 10)
        PH_BEGIN(pb + 11) phase_norm(XL, XC, mod, 6144, XN, ML); PH_END(pb + 11)
        PH_BEGIN(pb + 12) run_gemm(lds, XN, DM, WB + WE_UP2, 5632, DM, EpiUp{PA}, ML); PH_END(pb + 12)
        PH_BEGIN(pb + 13) run_gemm(lds, PA, DFF, WB + WE_DN2, DM, DFF, EpiRes{XL, XC, XL, XC, mod + 8192, 0.5f}, TL);
            if (l == 0) ctx_gemm(PA + (size_t)TL * DFF, DFF, WB + WE_DN2, DFF, FinRes{XC, XC, mod + 4 * NMOD + 8192, 0.5f}, lds); PH_END(pb + 13)
    }
    { const int pb = 1; PH_BEGIN(29) phase_final_norm(XL, a.in[23]); PH_END(29) }
#undef PH_BEGIN
#undef PH_END
}

#ifndef MK_N_LAUNCHES
#define MK_N_LAUNCHES 30
#endif
extern "C" void kernel_launch(void* const* d_in, const int* in_sizes, int n_in, void* d_out, int out_size, void* d_ws, size_t ws_size, hipStream_t stream) {
    static int grid = 0;
    if (grid == 0) {
        if (n_in != 24 || out_size != TL * DM || ws_size < WS_END) { fprintf(stderr, "kernel_launch: unexpected shapes (n_in %d out %d ws %zu)\n", n_in, out_size, ws_size); grid = -1; return; }
        int dev = 0, cus = 0, per_cu = 0;
        hipGetDevice(&dev); hipDeviceGetAttribute(&cus, hipDeviceAttributeMultiprocessorCount, dev);
        if (hipFuncSetAttribute((const void*)mk_fwd, hipFuncAttributeMaxDynamicSharedMemorySize, LDS_BYTES) != hipSuccess) { fprintf(stderr, "kernel_launch: hipFuncSetAttribute failed\n"); grid = -1; return; }
        if (hipOccupancyMaxActiveBlocksPerMultiprocessor(&per_cu, (const void*)mk_fwd, 512, LDS_BYTES) != hipSuccess || per_cu < 1) { fprintf(stderr, "kernel_launch: occupancy query says %d\n", per_cu); per_cu = 1; }
        (void)hipGetLastError();
        grid = cus * 1;
    }
    if (grid < 0) return;
    if (hipMemsetAsync((char*)d_ws + WS_CTL, 0, 16384, stream) != hipSuccess) { fprintf(stderr, "kernel_launch: hipMemsetAsync failed\n"); return; }
    KArgs a{};
    for (int i = 0; i < 24; ++i) a.in[i] = (const float*)d_in[i];
    a.out = (float*)d_out; a.ws = (unsigned char*)d_ws;
    if (MK_N_LAUNCHES == 1) {
        a.ph_lo = 0; a.ph_hi = NPHASE;
        void* args[] = {&a};
        hipError_t e = hipLaunchCooperativeKernel((const void*)mk_fwd, dim3(grid), dim3(512), args, LDS_BYTES, stream);
        if (e != hipSuccess) fprintf(stderr, "cooperative launch failed: %s (grid %d)\n", hipGetErrorString(e), grid);
    } else {
        for (int p = 0; p < NPHASE; ++p) { a.ph_lo = p; a.ph_hi = p + 1; hipLaunchKernelGGL(mk_fwd, dim3(grid), dim3(512), LDS_BYTES, stream, a); }
    }
}
```
